# Optimizing an MI355X kernel written in HIP

```python
import math
import jax, jax.numpy as jnp
from jax import lax
import numpy as np

D_MODEL = 1024
BATCH = 4
SEQ = 4096
DEPTH = 1

CONV_DIM = 512
CONV_GROUPS = 8
CONV_K = 3
HGRN_HEADS = 4
HGRN_DK = 128
HGRN_DV = 128
HGRN_FDIM = HGRN_HEADS * HGRN_DK
HGRN_VDIM = HGRN_HEADS * HGRN_DV
CHUNK = 32
N_BRANCH = 2
IN_COL_SIZES = (CONV_DIM, CONV_DIM, CONV_DIM,
                HGRN_FDIM, HGRN_FDIM, HGRN_FDIM, HGRN_VDIM, HGRN_VDIM,
                D_MODEL, D_MODEL)
IN_COLS = 3 * CONV_DIM + 3 * HGRN_FDIM + 2 * HGRN_VDIM + N_BRANCH * D_MODEL
N_EXPERTS = 32
TOP_K = 4
D_FF = D_MODEL
SWIGLU_ALPHA = 1.702
SWIGLU_LIMIT = 7.0
MOE_BLOCK = 256
DN_ALPHA = (2.0 * DEPTH) ** 0.25
DN_BETA = (8.0 * DEPTH) ** -0.25
LN_EPS = 1e-5
RMS_EPS = 1e-6

kernel_name = "hybrid_conv_hgrn2_moe_deepnorm_encoder"


def layer_norm(x, g, b):
    xf = x.astype(jnp.float32)
    mu = jnp.mean(xf, axis=-1, keepdims=True)
    xc = xf - mu
    var = jnp.mean(xc * xc, axis=-1, keepdims=True)
    return (xc * lax.rsqrt(var + LN_EPS) * g.astype(jnp.float32) + b.astype(jnp.float32)).astype(x.dtype)


def split_cols(proj):
    outs, start = [], 0
    for size in IN_COL_SIZES:
        outs.append(proj[..., start:start + size])
        start += size
    return outs


def centred_short_conv(u, w):
    L = u.shape[1]
    half = CONV_K // 2
    up = jnp.pad(u, ((0, 0), (half, half), (0, 0)))
    return sum(w[j] * up[:, j:j + L] for j in range(CONV_K))


def hgrn2_chunked(q, k, v, logf):
    Bsz, L, H, dk = q.shape
    dv = v.shape[-1]
    n = L // CHUNK

    def to_chunks(t):
        return t.reshape(Bsz, n, CHUNK, H, t.shape[-1]).transpose(0, 3, 1, 2, 4)

    q, k, v, logf = to_chunks(q), to_chunks(k), to_chunks(v), to_chunks(logf)
    b = jnp.cumsum(logf, axis=3)
    b_ref = b[:, :, :, CHUNK // 2 - 1:CHUNK // 2]
    b_last = b[:, :, :, CHUNK - 1:CHUNK]
    scores = jnp.einsum('bhntd,bhnsd->bhnts', q * jnp.exp(b - b_ref), k * jnp.exp(b_ref - b))
    causal_in_dir = jnp.tril(jnp.ones((CHUNK, CHUNK), dtype=bool))
    scores = jnp.where(causal_in_dir, scores, 0.0)
    o_intra = jnp.einsum('bhnts,bhnse->bhnte', scores, v)
    kv = jnp.einsum('bhnsd,bhnse->bhnde', k * jnp.exp(b_last - b), v)
    decay = jnp.exp(b_last[:, :, :, 0])

    def step(S, inp):
        kv_c, dec_c = inp
        return dec_c[..., None] * S + kv_c, S

    S0 = jnp.zeros((Bsz, H, dk, dv), jnp.float32)
    _, S_prev = lax.scan(step, S0, (kv.transpose(2, 0, 1, 3, 4), decay.transpose(2, 0, 1, 3)))
    S_prev = S_prev.transpose(1, 2, 0, 3, 4)
    o_inter = jnp.einsum('bhntd,bhnde->bhnte', q * jnp.exp(b), S_prev)
    o = o_intra + o_inter
    return o.transpose(0, 2, 3, 1, 4).reshape(Bsz, L, H, dv)


def hgrn2_gate(f_raw, lb):
    f = lb + (1.0 - lb) * jax.nn.sigmoid(f_raw.astype(jnp.float32))
    return jnp.log(f), 1.0 - f


def token_mixer(u, w_in, conv_w, p_a, lb_fwd, lb_bwd, norm_w, p_b, w_o):
    Bsz, L, _ = u.shape
    proj = u @ w_in
    c_b, c_c, c_h, q_raw, f_fw, f_bw, i_raw, g_raw, gate_a, gate_b = split_cols(proj)
    y_a = c_b * centred_short_conv(c_c * c_h, conv_w)
    heads = lambda t: t.reshape(Bsz, L, HGRN_HEADS, -1)
    q = heads(jax.nn.silu(q_raw.astype(jnp.float32)))
    v = heads(i_raw.astype(jnp.float32))
    logf_f, k_f = hgrn2_gate(f_fw, lb_fwd)
    logf_b, k_b = hgrn2_gate(f_bw, lb_bwd)
    o_fwd = hgrn2_chunked(q, heads(k_f), v, heads(logf_f))
    flip = lambda t: jnp.flip(t, axis=1)
    o_bwd = flip(hgrn2_chunked(flip(q), flip(heads(k_b)), flip(v), flip(heads(logf_b))))
    o = o_fwd + o_bwd
    o = o * lax.rsqrt(jnp.mean(o * o, axis=-1, keepdims=True) + RMS_EPS)
    o = o * norm_w.astype(jnp.float32).reshape(HGRN_HEADS, HGRN_DV)
    y_b = (o.reshape(Bsz, L, HGRN_VDIM) * jax.nn.silu(g_raw.astype(jnp.float32))).astype(u.dtype)
    mix = jax.nn.sigmoid(gate_a) * (y_a @ p_a) + jax.nn.sigmoid(gate_b) * (y_b @ p_b)
    return mix @ w_o


def clamped_swiglu_expert(xblk, w1e, b1e, w2e, b2e):
    h = xblk @ w1e + b1e
    h_glu = jnp.minimum(h[:, :D_FF], SWIGLU_LIMIT)
    h_lin = jnp.clip(h[:, D_FF:], -SWIGLU_LIMIT, SWIGLU_LIMIT)
    a = h_glu * jax.nn.sigmoid(SWIGLU_ALPHA * h_glu) * (h_lin + 1.0)
    return a @ w2e + b2e


def moe_ffn(x, w_router, b_router, w1, b1, w2, b2):
    Bsz, L, D = x.shape
    xt = x.reshape(-1, D)
    T = xt.shape[0]
    logits = (xt @ w_router + b_router).astype(jnp.float32)
    top_vals, top_idx = lax.top_k(logits, TOP_K)
    gates = jax.nn.softmax(top_vals, axis=-1)
    N = T * TOP_K
    e_flat = top_idx.reshape(-1).astype(jnp.int32)
    tok_flat = jnp.arange(N, dtype=jnp.int32) // TOP_K
    g_flat = gates.reshape(-1)
    order = jnp.argsort(e_flat)
    e_sorted = e_flat[order]
    counts = jnp.bincount(e_flat, length=N_EXPERTS).astype(jnp.int32)
    padded = ((counts + MOE_BLOCK - 1) // MOE_BLOCK) * MOE_BLOCK
    start = jnp.cumsum(counts) - counts
    ends_p = jnp.cumsum(padded)
    pstart = ends_p - padded
    dest = pstart[e_sorted] + (jnp.arange(N, dtype=jnp.int32) - start[e_sorted])
    n_blocks = -(-N // MOE_BLOCK) + N_EXPERTS
    P = n_blocks * MOE_BLOCK
    buf_tok = jnp.zeros((P,), jnp.int32).at[dest].set(tok_flat[order])
    buf_gate = jnp.zeros((P,), jnp.float32).at[dest].set(g_flat[order])
    block_start = jnp.arange(n_blocks, dtype=jnp.int32) * MOE_BLOCK
    block_expert = jnp.clip(jnp.searchsorted(ends_p, block_start, side='right'), 0, N_EXPERTS - 1)
    xb = xt[buf_tok].reshape(n_blocks, MOE_BLOCK, D)

    def run_block(args):
        xblk, e = args
        return clamped_swiglu_expert(xblk, w1[e], b1[e], w2[e], b2[e])

    yb = lax.map(run_block, (xb, block_expert)).reshape(P, D)
    yb = yb * buf_gate[:, None].astype(yb.dtype)
    out = jax.ops.segment_sum(yb, buf_tok, num_segments=T)
    return out.reshape(Bsz, L, D).astype(x.dtype)


def setup_inputs(seed: int = 0) -> dict:
    key = jax.random.key(seed)
    ks = jax.random.split(key, 20)
    f32 = jnp.float32

    def nrm(k, shape, s):
        return jax.random.normal(k, shape, f32) * s

    return {
        "x": nrm(ks[0], (BATCH, SEQ, D_MODEL), 1.0),
        "w_in": nrm(ks[1], (DEPTH, D_MODEL, IN_COLS), D_MODEL ** -0.5),
        "conv_w": nrm(ks[2], (DEPTH, CONV_K, CONV_DIM), CONV_K ** -0.5),
        "p_a": nrm(ks[3], (DEPTH, CONV_DIM, D_MODEL), CONV_DIM ** -0.5),
        "hgrn_lb_logits": nrm(ks[4], (2, DEPTH + 1, HGRN_FDIM), 0.3),
        "hgrn_norm_w": 1.0 + nrm(ks[5], (DEPTH, HGRN_VDIM), 0.02),
        "p_b": nrm(ks[6], (DEPTH, HGRN_VDIM, D_MODEL), HGRN_VDIM ** -0.5),
        "w_o": nrm(ks[7], (DEPTH, D_MODEL, D_MODEL), D_MODEL ** -0.5 * DN_BETA),
        "ln1_g": 1.0 + nrm(ks[8], (DEPTH, D_MODEL), 0.02),
        "ln1_b": nrm(ks[9], (DEPTH, D_MODEL), 0.02),
        "w_router": nrm(ks[10], (DEPTH, D_MODEL, N_EXPERTS), D_MODEL ** -0.5),
        "b_router": nrm(ks[11], (DEPTH, N_EXPERTS), 0.01),
        "w1": nrm(ks[12], (DEPTH, N_EXPERTS, D_MODEL, 2 * D_FF), D_MODEL ** -0.5),
        "b1": nrm(ks[13], (DEPTH, N_EXPERTS, 2 * D_FF), 0.01),
        "w2": nrm(ks[14], (DEPTH, N_EXPERTS, D_FF, D_MODEL), D_FF ** -0.5 * DN_BETA),
        "b2": nrm(ks[15], (DEPTH, N_EXPERTS, D_MODEL), 0.01),
        "ln2_g": 1.0 + nrm(ks[16], (DEPTH, D_MODEL), 0.02),
        "ln2_b": nrm(ks[17], (DEPTH, D_MODEL), 0.02),
    }


def reference(x, w_in, conv_w, p_a, hgrn_lb_logits, hgrn_norm_w, p_b, w_o, ln1_g, ln1_b,
              w_router, b_router, w1, b1, w2, b2, ln2_g, ln2_b):
    lb_table = jnp.cumsum(jax.nn.softmax(hgrn_lb_logits.astype(jnp.float32), axis=1), axis=1)
    h = x
    for l in range(DEPTH):
        mixed = token_mixer(h, w_in[l], conv_w[l], p_a[l], lb_table[0, l], lb_table[1, l],
                            hgrn_norm_w[l], p_b[l], w_o[l])
        h = layer_norm(DN_ALPHA * h + mixed, ln1_g[l], ln1_b[l])
        ffn = moe_ffn(h, w_router[l], b_router[l], w1[l], b1[l], w2[l], b2[l])
        h = layer_norm(DN_ALPHA * h + ffn, ln2_g[l], ln2_b[l])
    return h
```

```cpp
#include <hip/hip_runtime.h>
#include <cstdio>
#include <cstdint>

#ifndef MK_N_LAUNCHES
#define MK_N_LAUNCHES 1
#endif

#ifndef PROBE_DUP_MASK
#define PROBE_DUP_MASK 0
#endif
#define LAS __attribute__((address_space(3)))
#define GAS __attribute__((address_space(1)))
typedef unsigned short bf16_t;
typedef short bf16x8 __attribute__((ext_vector_type(8)));
typedef float f32x4 __attribute__((ext_vector_type(4)));
typedef float f32x2 __attribute__((ext_vector_type(2)));
typedef unsigned u32x4 __attribute__((ext_vector_type(4)));
typedef unsigned u32x2 __attribute__((ext_vector_type(2)));
typedef GAS unsigned gu32;

constexpr int NB = 4, SEQ = 4096, M = NB * SEQ, D = 1024, NIN = 6144, CD = 512, NH = 4, DKH = 128, NE = 32, TOPK = 4, DFF = 1024;
constexpr int C_CB = 0, C_CC = 512, C_CH = 1024, C_Q = 1536, C_FF = 2048, C_FB = 2560, C_V = 3072, C_G = 3584, C_GA = 4096, C_GB = 5120;
constexpr float DN_ALPHA = 1.189207115002721f, LN_EPS = 1e-5f, RMS_EPS = 1e-6f, SW_ALPHA = 1.702f, SW_LIMIT = 7.0f;
constexpr int NSLOT = M * TOPK + NE * 256;
constexpr int SC = 256, NSC = SEQ / SC;
constexpr int NUNIT_H = NB * NH * 2 * NSC;

constexpr size_t MiB = 1u << 20;
constexpr size_t WS_CTL = 0, CTL_ZERO_BYTES = 1 * MiB;
constexpr size_t WS_LB = 1 * MiB;
constexpr size_t WS_BLKCNT = 1 * MiB + 16 * 1024;
constexpr size_t WS_META = 1 * MiB + 64 * 1024;
constexpr size_t WS_TOPI = 1 * MiB + 128 * 1024;
constexpr size_t WS_TOPG = 1 * MiB + 384 * 1024;
constexpr size_t WS_POSOF = 1 * MiB + 640 * 1024;
constexpr size_t WS_SLOTTOK = 2 * MiB;
constexpr size_t WS_SLOTGATE = 2 * MiB + 512 * 1024;
constexpr size_t WS_DEC = 3 * MiB;
constexpr size_t WS_WIN = 4 * MiB;
constexpr size_t WS_PAB = 16 * MiB;
constexpr size_t WS_WO = 18 * MiB;
constexpr size_t WS_W1 = 20 * MiB;
constexpr size_t WS_W2 = 148 * MiB;
constexpr size_t WS_PROJ = 212 * MiB;
constexpr size_t WS_ACT = 212 * MiB;
constexpr size_t WS_XB = 404 * MiB;
constexpr size_t WS_YAB = 436 * MiB;
constexpr size_t WS_T1 = 468 * MiB;
constexpr size_t WS_MIX = 532 * MiB;
constexpr size_t WS_Y = 404 * MiB;
constexpr size_t WS_Z = 564 * MiB;
constexpr size_t WS_ODIR = 564 * MiB;
constexpr size_t WS_HF = 628 * MiB;
constexpr size_t WS_HB = 692 * MiB;
constexpr size_t WS_SLOC = 724 * MiB;
constexpr size_t WS_SIN = 756 * MiB;
constexpr size_t WS_END = 788 * MiB;
static_assert(WS_Y + (size_t)NSLOT * 1024 * 2 <= WS_Z && WS_ACT + (size_t)NSLOT * 1024 * 2 <= WS_XB, "overlay map");

constexpr int CW_BAR = 4096;

constexpr int RING_BYTES = 131072;
constexpr int LDS_BYTES = 163840;
constexpr int HG_OT_OFF = RING_BYTES;
constexpr int TOKBUF_OFF = LDS_BYTES - 4096;
constexpr int MOETS_OFF = TOKBUF_OFF + 2048;
constexpr int MISC_OFF = MOETS_OFF + 256;
static_assert(HG_OT_OFF + 16384 <= TOKBUF_OFF && MISC_OFF + 128 <= LDS_BYTES, "LDS map");
constexpr int NWAVES = 8;

__device__ __forceinline__ float bf2f(unsigned b) { return __uint_as_float(b << 16); }
__device__ __forceinline__ float bflo(unsigned w) { return __uint_as_float(w << 16); }
__device__ __forceinline__ float bfhi(unsigned w) { return __uint_as_float(w & 0xffff0000u); }
__device__ __forceinline__ unsigned f2bf(float f) { unsigned u = __float_as_uint(f); return (u + 0x7fffu + ((u >> 16) & 1u)) >> 16; }
__device__ __forceinline__ unsigned pk2(float lo, float hi) { return f2bf(lo) | (f2bf(hi) << 16); }
__device__ __forceinline__ float sigmoidf_(float x) { return __builtin_amdgcn_rcpf(1.0f + __expf(-x)); }
constexpr float Q_SH = 32.0f, Q_SW1 = 1024.0f, Q_SA = 4.0f, Q_SW2 = 2048.0f, Q_SY = 64.0f;
__device__ __forceinline__ unsigned pk4_fp8(float a, float b, float c, float d) {
    a = fminf(fmaxf(a, -448.f), 448.f); b = fminf(fmaxf(b, -448.f), 448.f); c = fminf(fmaxf(c, -448.f), 448.f); d = fminf(fmaxf(d, -448.f), 448.f);
    int w = 0; w = __builtin_amdgcn_cvt_pk_fp8_f32(a, b, w, false); w = __builtin_amdgcn_cvt_pk_fp8_f32(c, d, w, true); return (unsigned)w; }
__device__ __forceinline__ int fresh_lane() { int l; asm volatile("v_mbcnt_lo_u32_b32 %0, -1, 0\n\tv_mbcnt_hi_u32_b32 %0, -1, %0" : "=v"(l)); return l; }
__device__ __forceinline__ unsigned pk4_fp8_nc(float a, float b, float c, float d) { int w = 0; w = __builtin_amdgcn_cvt_pk_fp8_f32(a, b, w, false); w = __builtin_amdgcn_cvt_pk_fp8_f32(c, d, w, true); return (unsigned)w; }
__device__ __forceinline__ float wave_sum(float v) {
#pragma unroll
    for (int o = 1; o < 64; o <<= 1) v += __shfl_xor(v, o);
    return v;
}

namespace pg8 {
constexpr int BM = 256, BK = 64, HALF = 128, HTB = HALF * BK * 2, STAGE_BYTES = 8 * HTB, NXCD = 8, WGM = 8;
__host__ __device__ __forceinline__ int lds_byte(int r, int c) { const int st = (r >> 4) * 2 + (c >> 5), rr = r & 15, cc = c & 31, ob = rr * 64 + cc * 2; return st * 1024 + (ob ^ (((ob >> 9) & 1) << 5)); }
__host__ __device__ __forceinline__ void stage_rc(int b, int& R, int& C) { const int st = b / 1024, sb = b % 1024, swz = sb ^ (((sb >> 9) & 1) << 5); R = (st >> 1) * 16 + swz / 64; C = (st & 1) * 32 + (swz % 64) / 2; }
__host__ __device__ __forceinline__ int perm32(int rho) { const int n = rho >> 4, i = rho & 15; return 8 * (i >> 2) + 4 * n + (i & 3); }

struct Unit { int pm, pn, e; };

__device__ __forceinline__ int xcd_remap(int L, int nwg) { const int q = nwg / NXCD, r = nwg % NXCD, xcd = L % NXCD, off = L / NXCD; return (xcd < r ? xcd * (q + 1) : r * (q + 1) + (xcd - r) * q) + off; }

struct StaticOrder {
    const char* A; const char* Bt; int K; int nM, nN, nwg, G, c;
    __device__ void init(const void* A_, const void* Bt_, int M_, int N_, int K_, int G_, int c_) { A = (const char*)A_; Bt = (const char*)Bt_; K = K_; nM = M_ / BM; nN = N_ / BM; nwg = nM * nN; G = G_; c = c_; }
    __device__ __forceinline__ bool next(int i, Unit& u) const {
        const long L = (long)i * G + c; if (L >= nwg) return false;
        const int wgid = xcd_remap((int)L, nwg);
        const int nig = WGM * nN, gid = wgid / nig, fm = gid * WGM, gsz = (nM - fm) < WGM ? (nM - fm) : WGM;
        u.pm = fm + ((wgid % nig) % gsz); u.pn = (wgid % nig) / gsz; u.e = 0; return true;
    }
    __device__ __forceinline__ const char* a_base(const Unit& u) const { return A + (size_t)u.pm * BM * K * 2; }
    __device__ __forceinline__ const char* b_base(const Unit& u) const { return Bt + (size_t)u.pn * BM * K * 2; }
};
struct MoeOrder {
    const char* A; const char* Bt; int K; int NCT; int G, c; const LAS int* ts; bool gather;
    __device__ __forceinline__ bool next(int i, Unit& u) const {
        const int nwg = ts[NE] * NCT; const long L = (long)i * G + c; if (L >= nwg) return false;
        const int wgid = xcd_remap((int)L, nwg);
        int e = NE - 1;
        for (int e4 = 0; e4 < NE; e4 += 4) { const int a0 = ts[e4 + 1], a1 = ts[e4 + 2], a2 = ts[e4 + 3], a3 = ts[e4 + 4];
            if (wgid < a3 * NCT) { e = e4 + (wgid < a0 * NCT ? 0 : wgid < a1 * NCT ? 1 : wgid < a2 * NCT ? 2 : 3); break; } }
        const int r = wgid - ts[e] * NCT, R = ts[e + 1] - ts[e];
        u.pm = __builtin_amdgcn_readfirstlane(ts[e] + r % R); u.pn = __builtin_amdgcn_readfirstlane(r / R); u.e = __builtin_amdgcn_readfirstlane(e); return true;
    }
    __device__ __forceinline__ const char* a_base(const Unit& u) const { return gather ? A : A + (size_t)u.pm * BM * K * 2; }
    __device__ __forceinline__ const char* b_base(const Unit& u) const { return Bt + ((size_t)u.e * NCT + u.pn) * BM * K * 2; }
};

__device__ __forceinline__ unsigned cvt_pk_bf16(float lo, float hi) { unsigned r; asm volatile("v_cvt_pk_bf16_f32 %0, %1, %2" : "=v"(r) : "v"(lo), "v"(hi)); return r; }

typedef f32x4 Acc[2][2][4][2];

struct EpiProj {
    static constexpr bool PERM = true, HAS_MID = false;
    bf16_t* O; const float* lb;
    __device__ __forceinline__ void operator()(const Acc& acc, const Unit& u, int wr, int wc, int fr, int fq) const {
        const int row0 = u.pm * BM + wr * 64 + fr, col0 = u.pn * BM + wc * 32 + 8 * fq;
        const int pn = u.pn;
        int mode = 0;
        if ((pn >= 6 && pn < 8) || (pn >= 14 && pn < 16)) mode = 1; else if (pn >= 8 && pn < 12) mode = 2; else if (pn >= 16) mode = 3;
        float lbv[2][8];
#pragma unroll
        for (int bj = 0; bj < 2; ++bj)
#pragma unroll
            for (int j = 0; j < 8; ++j) lbv[bj][j] = 0.f;
        if (mode == 2) {
#pragma unroll
            for (int bj = 0; bj < 2; ++bj)
#pragma unroll
                for (int j = 0; j < 8; ++j) lbv[bj][j] = lb[col0 + bj * HALF + j - C_FF];
        }
#pragma unroll
        for (int ai = 0; ai < 2; ++ai)
#pragma unroll
            for (int m = 0; m < 4; ++m) { bf16_t* rowp = O + (size_t)(row0 + ai * HALF + m * 16) * NIN + col0;
                if (mode == 3) {
                    float v0[8], v1[8];
#pragma unroll
                    for (int p = 0; p < 4; ++p) { const f32x2 xa = {acc[ai][0][m][p >> 1][2 * (p & 1)], acc[ai][0][m][p >> 1][2 * (p & 1) + 1]}, xb = {acc[ai][1][m][p >> 1][2 * (p & 1)], acc[ai][1][m][p >> 1][2 * (p & 1) + 1]};
                        const f32x2 ta = xa * (-1.4426950408889634f), tb = xb * (-1.4426950408889634f);
                        f32x2 ea, eb; ea.x = __builtin_amdgcn_exp2f(ta.x); ea.y = __builtin_amdgcn_exp2f(ta.y); eb.x = __builtin_amdgcn_exp2f(tb.x); eb.y = __builtin_amdgcn_exp2f(tb.y);
                        const f32x2 da = ea + 1.0f, db = eb + 1.0f;
                        f32x2 ra, rb; ra.x = __builtin_amdgcn_rcpf(da.x); ra.y = __builtin_amdgcn_rcpf(da.y); rb.x = __builtin_amdgcn_rcpf(db.x); rb.y = __builtin_amdgcn_rcpf(db.y);
                        const f32x2 rr = db * ra;
                        v0[2 * p] = rr.x; v0[2 * p + 1] = rr.y; v1[2 * p] = rb.x; v1[2 * p + 1] = rb.y; }
                    u32x4 w0, w1; w0.x = cvt_pk_bf16(v0[0], v0[1]); w0.y = cvt_pk_bf16(v0[2], v0[3]); w0.z = cvt_pk_bf16(v0[4], v0[5]); w0.w = cvt_pk_bf16(v0[6], v0[7]);
                    w1.x = cvt_pk_bf16(v1[0], v1[1]); w1.y = cvt_pk_bf16(v1[2], v1[3]); w1.z = cvt_pk_bf16(v1[4], v1[5]); w1.w = cvt_pk_bf16(v1[6], v1[7]);
                    *(u32x4*)(rowp) = w0; *(u32x4*)(rowp + HALF) = w1;
                    continue; }
#pragma unroll
                for (int bj = 0; bj < 2; ++bj) { float v[8];
#pragma unroll
                    for (int p = 0; p < 4; ++p) { f32x2 x = {acc[ai][bj][m][p >> 1][2 * (p & 1)], acc[ai][bj][m][p >> 1][2 * (p & 1) + 1]};
                        if (mode != 0) { const f32x2 t = x * (-1.4426950408889634f); f32x2 e; e.x = __builtin_amdgcn_exp2f(t.x); e.y = __builtin_amdgcn_exp2f(t.y);
                            const f32x2 d = e + 1.0f; f32x2 sg; sg.x = __builtin_amdgcn_rcpf(d.x); sg.y = __builtin_amdgcn_rcpf(d.y);
                            if (mode == 1) x = x * sg;
                            else { const f32x2 l = {lbv[bj][2 * p], lbv[bj][2 * p + 1]}; const f32x2 f = l + (1.0f - l) * sg;
                                f32x2 lg; lg.x = __builtin_amdgcn_logf(f.x); lg.y = __builtin_amdgcn_logf(f.y); x = lg * 0.6931471805599453f; } }
                        v[2 * p] = x.x; v[2 * p + 1] = x.y; }
                    u32x4 w; w.x = cvt_pk_bf16(v[0], v[1]); w.y = cvt_pk_bf16(v[2], v[3]); w.z = cvt_pk_bf16(v[4], v[5]); w.w = cvt_pk_bf16(v[6], v[7]);
                    *(u32x4*)(rowp + bj * HALF) = w; } }
    }
};
struct EpiMix {
    static constexpr bool PERM = true, HAS_MID = true;
    const bf16_t* proj; bf16_t* MIX;
    __device__ __forceinline__ void mid(Acc& acc, const Unit& u, int wr, int wc, int fr, int fq) const {
        unsigned base = (unsigned)((u.pm * BM + wr * 64 + fr) * NIN + u.pn * 512 + wc * 32 + 8 * fq) * 2u;
        asm volatile("" : "+v"(base));
#pragma unroll
        for (int ai = 0; ai < 2; ++ai)
#pragma unroll
            for (int m = 0; m < 4; ++m) {
#pragma unroll
                for (int bj = 0; bj < 2; ++bj) { const unsigned off = base + (unsigned)(((ai * HALF + m * 16) * NIN + bj * 256) * 2);
                    const u32x4 gr = *(const u32x4*)((const char*)proj + C_GA * 2 + off);
#pragma unroll
                    for (int q = 0; q < 4; ++q) { acc[ai][bj][m][q >> 1][2 * (q & 1)] *= bflo(gr[q]); acc[ai][bj][m][q >> 1][2 * (q & 1) + 1] *= bfhi(gr[q]); } }
                asm volatile("" : "+v"(acc[ai][0][m][0]), "+v"(acc[ai][0][m][1]), "+v"(acc[ai][1][m][0]), "+v"(acc[ai][1][m][1])); }
    }
    __device__ __forceinline__ void operator()(const Acc& acc, const Unit& u, int wr, int wc, int fr, int fq) const {
        const int row0 = u.pm * BM + wr * 64 + fr, col0 = u.pn * BM + wc * 32 + 8 * fq;
        unsigned base = (unsigned)(row0 * NIN + u.pn * 512 + wc * 32 + 8 * fq) * 2u;
        asm volatile("" : "+v"(base));
#pragma unroll
        for (int ai = 0; ai < 2; ++ai)
#pragma unroll
            for (int m = 0; m < 4; ++m) { const size_t row = (size_t)(row0 + ai * HALF + m * 16);
#pragma unroll
                for (int bj = 0; bj < 2; ++bj) { const int col = col0 + bj * HALF; const unsigned off = base + (unsigned)(((ai * HALF + m * 16) * NIN + bj * 256) * 2);
                    const u32x4 g = *(const u32x4*)((const char*)proj + (C_GA + 128) * 2 + off);
                    const f32x4 a0 = acc[ai][bj][m][0], a1 = acc[ai][bj][m][1];
                    u32x4 w;
                    w.x = cvt_pk_bf16(bflo(g.x) * a0[0], bfhi(g.x) * a0[1]); w.y = cvt_pk_bf16(bflo(g.y) * a0[2], bfhi(g.y) * a0[3]);
                    w.z = cvt_pk_bf16(bflo(g.z) * a1[0], bfhi(g.z) * a1[1]); w.w = cvt_pk_bf16(bflo(g.w) * a1[2], bfhi(g.w) * a1[3]);
                    *(u32x4*)(MIX + row * D + col) = w; } }
    }
};
struct EpiResid {
    static constexpr bool PERM = true, HAS_MID = false;
    bf16_t* OUTB;
    __device__ __forceinline__ void operator()(const Acc& acc, const Unit& u, int wr, int wc, int fr, int fq) const {
        const int row0 = u.pm * BM + wr * 64 + fr, col0 = u.pn * BM + wc * 32 + 8 * fq;
#pragma unroll
        for (int ai = 0; ai < 2; ++ai)
#pragma unroll
            for (int m = 0; m < 4; ++m) { const size_t row = (size_t)(row0 + ai * HALF + m * 16);
#pragma unroll
                for (int bj = 0; bj < 2; ++bj) { const f32x4 a0 = acc[ai][bj][m][0], a1 = acc[ai][bj][m][1];
                    u32x4 w; w.x = cvt_pk_bf16(a0[0], a0[1]); w.y = cvt_pk_bf16(a0[2], a0[3]); w.z = cvt_pk_bf16(a1[0], a1[1]); w.w = cvt_pk_bf16(a1[2], a1[3]);
                    *(u32x4*)(OUTB + row * D + col0 + bj * HALF) = w; } }
    }
};
struct EpiSwiglu {
    static constexpr bool PERM = true, HAS_MID = false;
    unsigned char* ACT; const float* b1;
    __device__ __forceinline__ void operator()(const Acc& acc, const Unit& u, int wr, int wc, int fr, int fq) const {
        const int row0 = u.pm * BM + wr * 64 + fr, colc = u.pn * HALF + wc * 32 + 8 * fq;
        const float* bp = b1 + (size_t)u.e * (2 * DFF) + colc;
        const f32x4 bg0 = *(const f32x4*)(bp), bg1 = *(const f32x4*)(bp + 4), bl0 = *(const f32x4*)(bp + DFF), bl1 = *(const f32x4*)(bp + DFF + 4);
#pragma unroll
        for (int ai = 0; ai < 2; ++ai)
#pragma unroll
            for (int m = 0; m < 4; ++m) { const size_t row = (size_t)(row0 + ai * HALF + m * 16);
                float a[8];
#pragma unroll
                for (int n = 0; n < 2; ++n) { const f32x4 gb4 = n ? bg1 : bg0, lb4 = n ? bl1 : bl0;
#pragma unroll
                    for (int h2 = 0; h2 < 2; ++h2) {
                        f32x2 g = (f32x2){acc[ai][0][m][n][2 * h2], acc[ai][0][m][n][2 * h2 + 1]} * (1.0f / (Q_SH * Q_SW1)) + (f32x2){gb4[2 * h2], gb4[2 * h2 + 1]};
                        f32x2 l = (f32x2){acc[ai][1][m][n][2 * h2], acc[ai][1][m][n][2 * h2 + 1]} * (1.0f / (Q_SH * Q_SW1)) + (f32x2){lb4[2 * h2], lb4[2 * h2 + 1]};
                        g.x = fminf(g.x, SW_LIMIT); g.y = fminf(g.y, SW_LIMIT);
                        l.x = __builtin_amdgcn_fmed3f(l.x, -SW_LIMIT, SW_LIMIT); l.y = __builtin_amdgcn_fmed3f(l.y, -SW_LIMIT, SW_LIMIT);
                        const f32x2 t = g * (-SW_ALPHA * 1.4426950408889634f);
                        f32x2 e; e.x = __builtin_amdgcn_exp2f(t.x); e.y = __builtin_amdgcn_exp2f(t.y);
                        const f32x2 d = e + 1.0f;
                        f32x2 r; r.x = __builtin_amdgcn_rcpf(d.x); r.y = __builtin_amdgcn_rcpf(d.y);
                        const f32x2 o = (g * r) * (l * Q_SA + Q_SA);
                        a[4 * n + 2 * h2] = o.x; a[4 * n + 2 * h2 + 1] = o.y; } }
                u32x2 w; w.x = pk4_fp8_nc(a[0], a[1], a[2], a[3]); w.y = pk4_fp8_nc(a[4], a[5], a[6], a[7]);
                *(u32x2*)(ACT + row * DFF + colc) = w; }
    }
};
struct EpiMoeOut {
    static constexpr bool PERM = true, HAS_MID = false;
    unsigned char* Y; const float* b2; const float* slot_gate;
    __device__ __forceinline__ void operator()(const Acc& acc, const Unit& u, int wr, int wc, int fr, int fq) const {
        const int row0 = u.pm * BM + wr * 64 + fr, col0 = u.pn * BM + wc * 32 + 8 * fq;
        f32x4 bv[2][2];
#pragma unroll
        for (int bj = 0; bj < 2; ++bj)
#pragma unroll
            for (int n = 0; n < 2; ++n) bv[bj][n] = *(const f32x4*)(b2 + (size_t)u.e * D + col0 + bj * HALF + 4 * n);
#pragma unroll
        for (int ai = 0; ai < 2; ++ai)
#pragma unroll
            for (int m = 0; m < 4; ++m) { const size_t row = (size_t)(row0 + ai * HALF + m * 16); const float gt = slot_gate[row];
#pragma unroll
                for (int bj = 0; bj < 2; ++bj) { const float gs = gt * Q_SY; const f32x4 v0 = (acc[ai][bj][m][0] * (1.0f / (Q_SA * Q_SW2)) + bv[bj][0]) * gs, v1 = (acc[ai][bj][m][1] * (1.0f / (Q_SA * Q_SW2)) + bv[bj][1]) * gs;
                    u32x2 w; w.x = pk4_fp8(v0[0], v0[1], v0[2], v0[3]); w.y = pk4_fp8(v1[0], v1[1], v1[2], v1[3]);
                    *(u32x2*)(Y + row * D + col0 + bj * HALF) = w; } }
    }
};

typedef int i32x4 __attribute__((ext_vector_type(4)));
typedef int i32x8 __attribute__((ext_vector_type(8)));
template <bool GATHER, bool ALIGN_EPI, bool FP8, class Epi, class Sched>
__device__ __forceinline__ void gemm_phase(LAS unsigned char* lds, LAS unsigned* tokbuf, const int* tokidx, const int K, const Sched& S, const Epi& E, const int wid  ) {
    const int lane = fresh_lane(), tid = wid * 64 + lane, wr = wid >> 2, wc = wid & 3, fr = lane & 15, fq = lane >> 4;
    const int nt = K / BK;
    unsigned voffB[2], oA[2][2], cA2[2]; int RA[2];
    const unsigned hstep = (unsigned)HALF * (unsigned)K * 2u;
#pragma unroll
    for (int i = 0; i < 2; ++i) { int R, C; stage_rc(tid * 16 + i * 8192, R, C); const int Rb = Epi::PERM ? ((R & ~31) + perm32(R & 31)) : R;
        RA[i] = R; cA2[i] = (unsigned)C * 2u; voffB[i] = (unsigned)(Rb * K + C) * 2u;
        if constexpr (!GATHER) { oA[0][i] = (unsigned)(R * K + C) * 2u; oA[1][i] = oA[0][i] + hstep; } }
    const size_t kstep = (size_t)(BK * 2);
    const unsigned ldsw = (unsigned)wid * 1024u;
    const int aoff = lds_byte(wr * 64 + fr, fq * 8), boff = lds_byte(wc * 32 + fr, fq * 8);
#define PG8_SA(b, h) (((b) * 2 + (h)) * HTB)
#define PG8_SB(b, h) ((4 + (b) * 2 + (h)) * HTB)
#define PG8_STAGE(bufoff, gbase, voff) do { _Pragma("unroll") for (int _i = 0; _i < 2; ++_i) { unsigned vo_ = (voff)[_i]; asm volatile("" : "+v"(vo_));   \
        __builtin_amdgcn_global_load_lds((const unsigned*)((const char*)(gbase) + vo_), (LAS unsigned*)(lds + (bufoff) + ldsw + _i * 8192), 16, 0, 0); } } while (0)
#define PG8_LDA(dst, b, h) do { _Pragma("unroll") for (int m = 0; m < 4; ++m) { if constexpr (FP8) { \
            const i32x4 lo_ = *(const LAS i32x4*)(lds + PG8_SA(b, h) + aoff + m * 2048), hi_ = *(const LAS i32x4*)(lds + PG8_SA(b, h) + aoff + m * 2048 + 1024); \
            dst##8[m] = __builtin_shufflevector(lo_, hi_, 0, 1, 2, 3, 4, 5, 6, 7); } \
        else { _Pragma("unroll") for (int k = 0; k < 2; ++k) dst[m][k] = *(const LAS bf16x8*)(lds + PG8_SA(b, h) + aoff + m * 2048 + k * 1024); } } } while (0)
#define PG8_LDB(dst, b, h) do { _Pragma("unroll") for (int n = 0; n < 2; ++n) { if constexpr (FP8) { \
            const i32x4 lo_ = *(const LAS i32x4*)(lds + PG8_SB(b, h) + boff + n * 2048), hi_ = *(const LAS i32x4*)(lds + PG8_SB(b, h) + boff + n * 2048 + 1024); \
            dst##8[n] = __builtin_shufflevector(lo_, hi_, 0, 1, 2, 3, 4, 5, 6, 7); } \
        else { _Pragma("unroll") for (int k = 0; k < 2; ++k) dst[n][k] = *(const LAS bf16x8*)(lds + PG8_SB(b, h) + boff + n * 2048 + k * 1024); } } } while (0)
#define PG8_MMA(ai, bj, At, Bt) do { __builtin_amdgcn_s_setprio(1); _Pragma("unroll") for (int m = 0; m < 4; ++m) _Pragma("unroll") for (int n = 0; n < 2; ++n) { \
        if constexpr (FP8) acc[ai][bj][m][n] = __builtin_amdgcn_mfma_scale_f32_16x16x128_f8f6f4(Bt##8[n], At##8[m], acc[ai][bj][m][n], 0, 0, 0, 0x7F7F7F7F, 0, 0x7F7F7F7F); \
        else { _Pragma("unroll") for (int k = 0; k < 2; ++k) acc[ai][bj][m][n] = __builtin_amdgcn_mfma_f32_16x16x32_bf16(Bt[n][k], At[m][k], acc[ai][bj][m][n], 0, 0, 0); } } \
        __builtin_amdgcn_s_setprio(0); } while (0)
#define PG8_WAIT_V(n) asm volatile("s_waitcnt vmcnt(" #n ")" ::: "memory")
#define PG8_WAIT_L(n) asm volatile("s_waitcnt lgkmcnt(" #n ")" ::: "memory")
#define PG8_BAR __builtin_amdgcn_s_barrier()
#define PG8_SCHED __builtin_amdgcn_sched_barrier(0)
    Unit cur, nxt; int ui = 0;
    if (!S.next(0, cur)) return;
    Acc acc;
#pragma unroll
    for (int a = 0; a < 2; ++a)
#pragma unroll
        for (int b = 0; b < 2; ++b)
#pragma unroll
            for (int m = 0; m < 4; ++m)
#pragma unroll
                for (int n = 0; n < 2; ++n) acc[a][b][m][n] = (f32x4){0.f, 0.f, 0.f, 0.f};
    bf16x8 At[4][2], B0[2][2], B1[2][2]; i32x8 At8[4], B08[2], B18[2];
    const char* cA = S.a_base(cur); const char* cB = S.b_base(cur);
    if constexpr (GATHER) {
#pragma unroll
        for (int h = 0; h < 2; ++h)
#pragma unroll
            for (int i = 0; i < 2; ++i) oA[h][i] = (unsigned)tokidx[cur.pm * BM + h * HALF + RA[i]] * (unsigned)(K * 2) + cA2[i];
    }
    PG8_STAGE(PG8_SB(0, 0), cB, voffB); PG8_STAGE(PG8_SB(0, 1), cB + hstep, voffB); PG8_STAGE(PG8_SA(0, 0), cA, oA[0]); PG8_STAGE(PG8_SA(0, 1), cA, oA[1]);
    if (wr == 1) PG8_BAR;
    PG8_WAIT_V(2); PG8_BAR;
    PG8_STAGE(PG8_SB(1, 0), cB + kstep, voffB); PG8_STAGE(PG8_SA(1, 0), cA + kstep, oA[0]); PG8_STAGE(PG8_SB(1, 1), cB + hstep + kstep, voffB);
    PG8_WAIT_V(6); PG8_BAR;
    for (;;) {
        const bool has_next = S.next(ui + 1, nxt);
        const char* nA = has_next ? S.a_base(nxt) : cA; const char* nB = has_next ? S.b_base(nxt) : cB;
        if constexpr (GATHER) {
            if (has_next && wid < 4)
                __builtin_amdgcn_global_load_lds((const unsigned*)(tokidx + nxt.pm * BM + tid), (LAS unsigned*)(tokbuf + ((ui + 1) & 1) * 256 + wid * 64), 4, 0, 0);
        }
#pragma nounroll
        for (int t = 0; t < nt; t += 2) {
            const bool last = (t == nt - 2);
            if constexpr (Epi::HAS_MID) { if (t == nt / 2) E.mid(acc, cur, wr, wc, fr, fq); }
            const char* a1 = cA + (size_t)(t + 1) * kstep;
            const char* a2 = last ? nA : cA + (size_t)(t + 2) * kstep; const char* b2 = last ? nB : cB + (size_t)(t + 2) * kstep;
            const char* a3 = a2 + kstep; const char* b3 = b2 + kstep;
            PG8_LDB(B0, 0, 0); PG8_LDB(B1, 0, 1); PG8_SCHED; PG8_LDA(At, 0, 0); PG8_STAGE(PG8_SA(1, 1), a1, oA[1]);
            PG8_WAIT_V(8); PG8_WAIT_L(0); PG8_BAR; PG8_MMA(0, 0, At, B0); PG8_MMA(0, 1, At, B1); PG8_BAR; PG8_SCHED;
            if constexpr (GATHER) {
                if (last && has_next) {
#pragma unroll
                    for (int h = 0; h < 2; ++h)
#pragma unroll
                        for (int i = 0; i < 2; ++i) oA[h][i] = tokbuf[((ui + 1) & 1) * 256 + h * HALF + RA[i]] * (unsigned)(K * 2) + cA2[i];
                }
            }
            PG8_LDA(At, 0, 1); PG8_STAGE(PG8_SB(0, 0), b2, voffB); PG8_STAGE(PG8_SB(0, 1), b2 + hstep, voffB); PG8_STAGE(PG8_SA(0, 0), a2, oA[0]);
            PG8_WAIT_V(8); PG8_WAIT_L(0); PG8_BAR; PG8_MMA(1, 0, At, B0); PG8_MMA(1, 1, At, B1); PG8_BAR; PG8_SCHED;
            PG8_LDB(B0, 1, 0); PG8_LDB(B1, 1, 1); PG8_SCHED; PG8_LDA(At, 1, 0); PG8_STAGE(PG8_SA(0, 1), a2, oA[1]);
            PG8_WAIT_V(8); PG8_WAIT_L(0); PG8_BAR; PG8_MMA(0, 0, At, B0); PG8_MMA(0, 1, At, B1); PG8_BAR; PG8_SCHED;
            PG8_LDA(At, 1, 1); PG8_STAGE(PG8_SB(1, 0), b3, voffB); PG8_STAGE(PG8_SB(1, 1), b3 + hstep, voffB); PG8_STAGE(PG8_SA(1, 0), a3, oA[0]);
            PG8_WAIT_V(8); PG8_WAIT_L(0); PG8_BAR; PG8_MMA(1, 0, At, B0); PG8_MMA(1, 1, At, B1); PG8_BAR; PG8_SCHED;
        }
        if constexpr (ALIGN_EPI) { if (wr == 0) PG8_BAR; }
        E(acc, cur, wr, wc, fr, fq);
        if (!has_next) break;
#pragma unroll
        for (int a = 0; a < 2; ++a)
#pragma unroll
            for (int b = 0; b < 2; ++b)
#pragma unroll
                for (int m = 0; m < 4; ++m)
#pragma unroll
                    for (int n = 0; n < 2; ++n) acc[a][b][m][n] = (f32x4){0.f, 0.f, 0.f, 0.f};
        cur = nxt; cA = nA; cB = nB; ++ui;
        if constexpr (ALIGN_EPI) { if (wr == 1) PG8_BAR; }
    }
    PG8_WAIT_V(0);
    if constexpr (!ALIGN_EPI) { if (wr == 0) PG8_BAR; }
    PG8_BAR;
#undef PG8_SA
#undef PG8_SB
#undef PG8_STAGE
#undef PG8_LDA
#undef PG8_LDB
#undef PG8_MMA
#undef PG8_WAIT_V
#undef PG8_WAIT_L
#undef PG8_BAR
#undef PG8_SCHED
}
}

#define XB_TMO      128
#define XB_XCNT(j)  (256  + 64 * (j))
#define XB_XSUB(j)  (1280 + 64 * (j))
#define XB_XGEN(j)  (2304 + 64 * (j))
#define XB_TOP      3328
#define XB_TOPGEN   3392
#define XCD_BAR_WORDS 3456
#define XB_SPIN_CAP (1u << 18)
__device__ __forceinline__ unsigned xb_ld(unsigned* p)              { return __hip_atomic_load(p, __ATOMIC_RELAXED, __HIP_MEMORY_SCOPE_AGENT); }
__device__ __forceinline__ unsigned xb_add(unsigned* p, unsigned v) { return __hip_atomic_fetch_add(p, v, __ATOMIC_RELAXED, __HIP_MEMORY_SCOPE_AGENT); }
__device__ __forceinline__ unsigned xb_xcc_id() { return (unsigned)__builtin_amdgcn_s_getreg((3 << 11) | 20) & 0xFu; }
#define XB_SPIN(cond, bar) do { unsigned _sp = 0; while (cond) { __builtin_amdgcn_s_sleep(1); \
    if ((++_sp & 255u) == 0u) { if (xb_ld(&(bar)[XB_TMO])) break; if (_sp > XB_SPIN_CAP) { atomicAdd(&(bar)[XB_TMO], 1u); break; } } } } while (0)
struct XcdBarrier { unsigned* bar; unsigned x; volatile LAS unsigned* st; };
__device__ __forceinline__ XcdBarrier xcd_barrier_post(unsigned* bar, volatile LAS unsigned* st, bool thread0) {
    XcdBarrier b; b.bar = bar; b.x = xb_xcc_id(); b.st = st;
    if (thread0) (void)xb_add(&bar[XB_XCNT(b.x)], 1u);
    return b;
}
__device__ __forceinline__ void xcd_barrier_complete(unsigned* bar, unsigned x, unsigned& nloc, unsigned& nx) {
    const unsigned G = gridDim.x * gridDim.y * gridDim.z;
    unsigned sum, cnt, mine, sp = 0u;
    for (;;) {
        sum = 0u; cnt = 0u; mine = 0u;
#pragma unroll
        for (unsigned j = 0; j < 16; ++j) { const unsigned c = xb_ld(&bar[XB_XCNT(j)]); sum += c; cnt += (c > 0u) ? 1u : 0u; mine = (j == x) ? c : mine; }
        if (sum == G) break;
        __builtin_amdgcn_s_sleep(1);
        if ((++sp & 255u) == 0u) { if (xb_ld(&bar[XB_TMO])) break; if (sp > XB_SPIN_CAP) { atomicAdd(&bar[XB_TMO], 1u); break; } }
    }
    nloc = mine > 0u ? mine : 1u; nx = cnt > 0u ? cnt : 1u;
}
__device__ __forceinline__ void xcd_barrier(const XcdBarrier& b, bool thread0  ) {
    asm volatile("s_waitcnt vmcnt(0)" ::: "memory");
    __syncthreads();
    if (thread0) {
        unsigned* bar = b.bar;
        __builtin_amdgcn_s_waitcnt(0);
        unsigned nloc = b.st[0], nx = b.st[1];
        if (nloc == 0u) { xcd_barrier_complete(bar, b.x, nloc, nx); b.st[0] = nloc; b.st[1] = nx; }
        const unsigned old = xb_add(&bar[XB_XSUB(b.x)], 1u);
        const unsigned gen = old / nloc;
        if (old + 1u == (gen + 1u) * nloc) {
            __builtin_amdgcn_fence(__ATOMIC_RELEASE, "agent");
            asm volatile("s_waitcnt vmcnt(0)" ::: "memory");
            const unsigned og = xb_add(&bar[XB_TOP], 1u);
            const unsigned tg = og / nx;
            if (og + 1u == (tg + 1u) * nx) xb_add(&bar[XB_TOPGEN], 1u);
            else XB_SPIN(xb_ld(&bar[XB_TOPGEN]) == tg, bar);
            __builtin_amdgcn_fence(__ATOMIC_ACQUIRE, "agent");
            xb_add(&bar[XB_XGEN(b.x)], 1u);
            asm volatile("s_waitcnt vmcnt(0)" ::: "memory");
        } else {
            XB_SPIN(xb_ld(&bar[XB_XGEN(b.x)]) == gen, bar);
            __builtin_amdgcn_fence(__ATOMIC_ACQUIRE, "agent");
            asm volatile("s_waitcnt vmcnt(0)" ::: "memory");
        }
    }
    __syncthreads();
}

struct Frame {
    LAS unsigned char* lds;
    volatile LAS unsigned* MISC;
    gu32* ctl;
    int tid, lane, wave;
    int vcu, G;
    const float *x, *w_in, *conv_w, *p_a, *lb_logits, *norm_w, *p_b, *w_o, *ln1_g, *ln1_b, *w_router, *b_router, *w1, *b1, *w2, *b2, *ln2_g, *ln2_b;
    float* out;
    unsigned char* ws;
};
#define WSP(T, off) ((T*)(F.ws + (off)))

__device__ __forceinline__ void p0_transpose_item(const float* W, int K, int N, bf16_t* WT, int k0, int n0, int dst_row0, LAS float* scr, int lane, int ldk = 0, int kdst0 = 0) {
    if (ldk == 0) ldk = K;
#pragma unroll 8
    for (int i = 0; i < 32; ++i) { const int kk = 2 * i + (lane >> 5); scr[kk * 33 + (lane & 31)] = W[(size_t)(k0 + kk) * N + n0 + (lane & 31)]; }
    asm volatile("s_waitcnt lgkmcnt(0)" ::: "memory");
    const int c = lane & 7;
#pragma unroll
    for (int j = 0; j < 4; ++j) { const int n = (lane >> 3) + 8 * j; const LAS float* s = scr + (8 * c) * 33 + n;
        u32x4 o; o.x = pk2(s[0 * 33], s[1 * 33]); o.y = pk2(s[2 * 33], s[3 * 33]); o.z = pk2(s[4 * 33], s[5 * 33]); o.w = pk2(s[6 * 33], s[7 * 33]);
        *(u32x4*)(WT + (size_t)(dst_row0 + n) * ldk + kdst0 + k0 + 8 * c) = o; }
    asm volatile("s_waitcnt lgkmcnt(0)" ::: "memory");
}
__device__ __forceinline__ void p0_transpose_item_fp8(const float* W, int K, int N, unsigned char* WT, int k0, int n0, int dst_row0, float scale, LAS float* scrf, int lane) {
    LAS unsigned char* scr = (LAS unsigned char*)scrf;
    float r[64];
    { const float* p = W + (size_t)(k0 + (lane >> 5)) * N + n0 + (lane & 31);
#pragma unroll
      for (int i = 0; i < 64; ++i) r[i] = __builtin_nontemporal_load(p + (size_t)(2 * i) * N); }
#pragma unroll
    for (int q = 0; q < 32; ++q) {
        const float a = r[2 * q], b = r[2 * q + 1];
        const float ao = __shfl_xor(a, 32), bo = __shfl_xor(b, 32);
        if ((q & 1) == (lane >> 5)) { const float v0 = (lane >> 5) ? ao : a, v1 = (lane >> 5) ? a : ao, v2 = (lane >> 5) ? bo : b, v3 = (lane >> 5) ? b : bo;
            *(LAS unsigned*)(scr + (lane & 31) * 144 + 4 * q) = pk4_fp8(v0 * scale, v1 * scale, v2 * scale, v3 * scale); }
    }
    asm volatile("s_waitcnt lgkmcnt(0)" ::: "memory");
    const int c = lane & 7;
#pragma unroll
    for (int j = 0; j < 4; ++j) { const int n = (lane >> 3) + 8 * j;
        const u32x4 o = *(const LAS u32x4*)(scr + n * 144 + 16 * c);
        *(u32x4*)(WT + (size_t)(dst_row0 + n) * K + k0 + 16 * c) = o; }
    asm volatile("s_waitcnt lgkmcnt(0)" ::: "memory");
}
template <int PART>
__device__ __forceinline__ void p0_prologue(Frame& F) {
    LAS float* scr = (LAS float*)(F.lds + F.wave * 16384);
    const int gw = F.vcu * NWAVES + F.wave, NGW = F.G * NWAVES;
    if (PART == 0) { bf16_t* XB = WSP(bf16_t, WS_XB);
    for (int m0 = F.vcu * NWAVES + F.wave; m0 < M; m0 += 8 * F.G * NWAVES) {
        f32x4 xv[8][4];
#pragma unroll
        for (int q = 0; q < 8; ++q) { const int m = m0 + q * F.G * NWAVES; if (m < M) { const f32x4* xr = (const f32x4*)(F.x + (size_t)m * D) + F.lane;
#pragma unroll
            for (int j = 0; j < 4; ++j) xv[q][j] = __builtin_nontemporal_load(xr + 64 * j); } }
#pragma unroll
        for (int q = 0; q < 8; ++q) { const int m = m0 + q * F.G * NWAVES; if (m < M) { unsigned long long* o8 = (unsigned long long*)(XB + (size_t)m * D) + F.lane;
#pragma unroll
            for (int j = 0; j < 4; ++j) o8[64 * j] = (unsigned long long)pk2(xv[q][j][0], xv[q][j][1]) | ((unsigned long long)pk2(xv[q][j][2], xv[q][j][3]) << 32); } }
    } }
    constexpr int I_WIN = (D / 64) * (NIN / 32), I_PA = (CD / 64) * (D / 32), I_PB = I_PA, I_WO = (D / 64) * (D / 32);
    constexpr int I_W1E = (D / 128) * (2 * DFF / 32), I_W1 = NE * I_W1E, I_W2E = (DFF / 128) * (D / 32), I_W2 = NE * I_W2E;
    constexpr int NITEMS = I_WIN + I_PA + I_PB + I_WO + I_W1 + I_W2;
    constexpr int IT_LO = PART == 0 ? 0 : I_WIN + I_PA + I_PB + I_WO, IT_HI = PART == 0 ? I_WIN + I_PA + I_PB + I_WO : NITEMS;
    for (int it = IT_LO + gw; it < IT_HI; it += NGW) {
        int r = it;
        if (r < I_WIN) { const int nblk = NIN / 32, kb = r / nblk, nb = r % nblk; const int n0 = 32 * nb;
            int dst = n0; if (n0 >= C_GA) { const int isb = n0 >= C_GB ? 1 : 0, jj = n0 - (isb ? C_GB : C_GA); dst = C_GA + 256 * (jj / 128) + 128 * isb + (jj % 128); }
            p0_transpose_item(F.w_in, D, NIN, WSP(bf16_t, WS_WIN), 64 * kb, n0, dst, scr, F.lane); continue; } r -= I_WIN;
        if (r < I_PA) { const int nblk = D / 32, kb = r / nblk, nb = r % nblk; p0_transpose_item(F.p_a, CD, D, WSP(bf16_t, WS_PAB), 64 * kb, 32 * nb, 32 * nb, scr, F.lane, D, 0); continue; } r -= I_PA;
        if (r < I_PB) { const int nblk = D / 32, kb = r / nblk, nb = r % nblk; p0_transpose_item(F.p_b, CD, D, WSP(bf16_t, WS_PAB), 64 * kb, 32 * nb, 32 * nb, scr, F.lane, D, CD); continue; } r -= I_PB;
        if (r < I_WO) { const int nblk = D / 32, kb = r / nblk, nb = r % nblk; p0_transpose_item(F.w_o, D, D, WSP(bf16_t, WS_WO), 64 * kb, 32 * nb, 32 * nb, scr, F.lane); continue; } r -= I_WO;
        if (r < I_W1) { const int e = r / I_W1E, rr = r % I_W1E; const int nblk = 2 * DFF / 32, kb = rr / nblk, nb = rr % nblk; const int n0 = 32 * nb;
            const int bj = n0 >= DFF ? 1 : 0, cc = n0 - bj * DFF, dst = 256 * (cc / 128) + 128 * bj + (cc % 128);
            p0_transpose_item_fp8(F.w1 + (size_t)e * D * 2 * DFF, D, 2 * DFF, WSP(unsigned char, WS_W1) + (size_t)e * 2 * DFF * D, 128 * kb, n0, dst, Q_SW1, scr, F.lane); continue; } r -= I_W1;
        { const int e = r / I_W2E, rr = r % I_W2E; const int nblk = D / 32, kb = rr / nblk, nb = rr % nblk;
            p0_transpose_item_fp8(F.w2 + (size_t)e * DFF * D, DFF, D, WSP(unsigned char, WS_W2) + (size_t)e * D * DFF, 128 * kb, 32 * nb, 32 * nb, Q_SW2, scr, F.lane); }
    }
    if (PART != 0) return;
    if (blockIdx.x == 0) { float* LB = WSP(float, WS_LB);
        for (int i = F.tid; i < 2 * 512; i += NWAVES * 64) { const int dir = i >> 9, c = i & 511; const float l0 = F.lb_logits[(dir * 2 + 0) * 512 + c], l1 = F.lb_logits[(dir * 2 + 1) * 512 + c];
            LB[i] = 1.0f / (1.0f + expf(l1 - l0)); } }
}

typedef float f32x16 __attribute__((ext_vector_type(16)));
constexpr int HG_QT = 0, HG_KT = 8704, HG_KTT = 17408, HG_VT = 27648, HG_SA = 37888, HG_SB = 38400, HG_DS = 38912, HG_HALFB = 40960;
constexpr int HG_RAW = 2 * HG_HALFB, HG_RAWB = 24576;
static_assert(HG_RAW + 2 * HG_RAWB <= RING_BYTES, "HGRN LDS map");
constexpr int HG_RP = 272, HG_TP = 80;
__device__ __forceinline__ unsigned cvtpk_c(float lo, float hi) { typedef float f2_t __attribute__((ext_vector_type(2))); typedef __bf16 b2_t __attribute__((ext_vector_type(2)));
    f2_t v = {lo, hi}; b2_t b = __builtin_convertvector(v, b2_t); return __builtin_bit_cast(unsigned, b); }
__device__ __forceinline__ int crow(int r, int hh) { return (r & 3) + 8 * (r >> 2) + 4 * hh; }
#define MFMA32(a, b, c) __builtin_amdgcn_mfma_f32_32x32x16_bf16((a), (b), (c), 0, 0, 0)
#define PACK8(x, s) __builtin_bit_cast(bf16x8, (u32x4){cvtpk_c((x)[8 * (s) + 0], (x)[8 * (s) + 1]), cvtpk_c((x)[8 * (s) + 2], (x)[8 * (s) + 3]), cvtpk_c((x)[8 * (s) + 4], (x)[8 * (s) + 5]), cvtpk_c((x)[8 * (s) + 6], (x)[8 * (s) + 7])})
#define HG_LDS_BARRIER() do { asm volatile("s_waitcnt lgkmcnt(0)" ::: "memory"); __builtin_amdgcn_s_barrier(); asm volatile("" ::: "memory"); } while (0)
template <bool PASS_C>
__device__ __forceinline__ void hgrn_mfma_unit(Frame& F, int unit) {
    const int j = unit & 15, hd = (unit >> 4) & 3, b = unit >> 6;
    const int tid = F.tid, dir = tid >> 8, ltid = tid & 255, c = ltid & 127, hf = ltid >> 7;
    const int lane = tid & 63, w = (tid >> 6) & 3, r32 = lane & 31, hh = lane >> 5;
    LAS unsigned char* L = F.lds + dir * HG_HALFB;
    const int udir = ((b * 4 + hd) * 2 + dir) * 16 + (dir ? 15 - j : j);
    const bf16_t* P = WSP(const bf16_t, WS_PROJ) + (size_t)(b * SEQ) * NIN;
    const int tbase = dir ? (j * SC + SC - 1) : (j * SC), tstep = dir ? -1 : 1;
    f32x16 S[4];
    if (PASS_C) { const f32x4* sin_ = (const f32x4*)(WSP(const float, WS_SLOC) + (size_t)udir * 16384) + (w * 16) * 64 + lane;
#pragma unroll
        for (int db = 0; db < 4; ++db)
#pragma unroll
            for (int g = 0; g < 4; ++g) { const f32x4 v4 = sin_[(db * 4 + g) * 64];
#pragma unroll
                for (int cc = 0; cc < 4; ++cc) S[db][4 * g + cc] = v4[cc]; }
    } else {
#pragma unroll
        for (int db = 0; db < 4; ++db)
#pragma unroll
            for (int i = 0; i < 16; ++i) S[db][i] = 0.f;
    }
    float lsum = 0.f;
    LAS unsigned char* RAW = F.lds + HG_RAW + dir * HG_RAWB;
    const char* Pb = (const char*)P;
    const unsigned cf0 = (unsigned)((dir ? C_FB : C_FF) + hd * 128) * 2u, cv0 = (unsigned)(C_V + hd * 128) * 2u, cq0 = (unsigned)(C_Q + hd * 128) * 2u;
#define HG_DMA(sc_) do { _Pragma("unroll") for (int k_ = 0; k_ < 2; ++k_) { const int i_ = 8 * w + 4 * k_ + (lane >> 4); \
        unsigned go_ = (unsigned)(tbase + tstep * (32 * (sc_) + i_)) * (unsigned)(NIN * 2) + (unsigned)(lane & 15) * 16u; asm volatile("" : "+v"(go_)); \
        __builtin_amdgcn_global_load_lds((const unsigned*)(Pb + cf0 + go_), (LAS unsigned*)(RAW + (8 * w + 4 * k_) * 256), 16, 0, 0); \
        __builtin_amdgcn_global_load_lds((const unsigned*)(Pb + cv0 + go_), (LAS unsigned*)(RAW + 8192 + (8 * w + 4 * k_) * 256), 16, 0, 0); \
        if (PASS_C) __builtin_amdgcn_global_load_lds((const unsigned*)(Pb + cq0 + go_), (LAS unsigned*)(RAW + 16384 + (8 * w + 4 * k_) * 256), 16, 0, 0); } } while (0)
    HG_DMA(0);
    asm volatile("s_waitcnt vmcnt(0)" ::: "memory");
    HG_LDS_BARRIER();
    for (int sc = 0; sc < 8; ++sc) {
        { unsigned short rl[16], rq[16], rv[16];
#pragma unroll
          for (int ii = 0; ii < 16; ++ii) { const LAS unsigned char* rp = RAW + (16 * hf + ii) * 256 + c * 2;
              rl[ii] = *(const LAS unsigned short*)(rp); rv[ii] = *(const LAS unsigned short*)(rp + 8192); rq[ii] = PASS_C ? *(const LAS unsigned short*)(rp + 16384) : (unsigned short)0; }
          float cs[16]; float run = 0.f;
#pragma unroll
          for (int ii = 0; ii < 16; ++ii) { run += bf2f(rl[ii]); cs[ii] = run; }
          const float tot = run; lsum += tot;
          unsigned ktp[8], vtp[8];
#pragma unroll
          for (int p = 0; p < 8; ++p) {
              float kt2[2], qt2[2];
#pragma unroll
              for (int q = 0; q < 2; ++q) { const int ii = 2 * p + q; const float x = hf ? cs[ii] : cs[ii] - tot;
                  const float kk = 1.0f - __expf(bf2f(rl[ii]));
                  kt2[q] = kk * __expf(-x); qt2[q] = PASS_C ? bf2f(rq[ii]) * __expf(x) : 0.f; }
              const unsigned kp = cvtpk_c(kt2[0], kt2[1]); ktp[p] = kp; vtp[p] = (unsigned)rv[2 * p] | ((unsigned)rv[2 * p + 1] << 16);
              if (PASS_C) { const unsigned qp = cvtpk_c(qt2[0], qt2[1]); const int i0 = 16 * hf + 2 * p;
                  *(LAS unsigned short*)(L + HG_KT + i0 * HG_RP + c * 2) = (unsigned short)(kp & 0xffffu); *(LAS unsigned short*)(L + HG_KT + (i0 + 1) * HG_RP + c * 2) = (unsigned short)(kp >> 16);
                  *(LAS unsigned short*)(L + HG_QT + i0 * HG_RP + c * 2) = (unsigned short)(qp & 0xffffu); *(LAS unsigned short*)(L + HG_QT + (i0 + 1) * HG_RP + c * 2) = (unsigned short)(qp >> 16); }
          }
          *(LAS u32x4*)(L + HG_KTT + c * HG_TP + hf * 32) = (u32x4){ktp[0], ktp[1], ktp[2], ktp[3]}; *(LAS u32x4*)(L + HG_KTT + c * HG_TP + hf * 32 + 16) = (u32x4){ktp[4], ktp[5], ktp[6], ktp[7]};
          *(LAS u32x4*)(L + HG_VT + c * HG_TP + hf * 32) = (u32x4){vtp[0], vtp[1], vtp[2], vtp[3]}; *(LAS u32x4*)(L + HG_VT + c * HG_TP + hf * 32 + 16) = (u32x4){vtp[4], vtp[5], vtp[6], vtp[7]};
          *(LAS float*)(L + (hf ? HG_SB : HG_SA) + c * 4) = __expf(tot);
        }
        HG_LDS_BARRIER();
        if (sc + 1 < 8) HG_DMA(sc + 1);
        const LAS unsigned char* vrow = L + HG_VT + (32 * w + r32) * HG_TP;
        const LAS unsigned char* qrow = L + HG_QT + r32 * HG_RP;
        f32x16 O;
        if (PASS_C) {
            f32x16 X;
#pragma unroll
            for (int i = 0; i < 16; ++i) { X[i] = 0.f; O[i] = 0.f; }
            const LAS unsigned char* krow = L + HG_KT + r32 * HG_RP + hh * 16;
#pragma unroll
            for (int ks = 0; ks < 8; ++ks) { const bf16x8 a = *(const LAS bf16x8*)(krow + ks * 32), bq = *(const LAS bf16x8*)(qrow + hh * 16 + ks * 32); X = MFMA32(a, bq, X); }
#pragma unroll
            for (int i = 0; i < 16; ++i) X[i] = (crow(i, hh) <= r32) ? X[i] : 0.f;
            const bf16x8 pa0 = PACK8(X, 0), pa1 = PACK8(X, 1);
#pragma unroll
            for (int ks = 0; ks < 2; ++ks) { const u32x2 lo = *(const LAS u32x2*)(vrow + (16 * ks + 4 * hh) * 2), hi = *(const LAS u32x2*)(vrow + (16 * ks + 8 + 4 * hh) * 2);
                const bf16x8 vb = __builtin_bit_cast(bf16x8, (u32x4){lo.x, lo.y, hi.x, hi.y}); O = MFMA32(ks ? pa1 : pa0, vb, O); }
        }
#pragma unroll
        for (int db = 0; db < 4; ++db)
#pragma unroll
            for (int g = 0; g < 4; ++g) { const f32x4 f4 = *(const LAS f32x4*)(L + HG_SA + (32 * db + 8 * g + 4 * hh) * 4);
#pragma unroll
                for (int cc = 0; cc < 4; ++cc) S[db][4 * g + cc] *= f4[cc]; }
        if (PASS_C) {
#pragma unroll
            for (int db = 0; db < 4; ++db)
#pragma unroll
                for (int ks = 0; ks < 2; ++ks) { const bf16x8 sb = PACK8(S[db], ks);
                    const u32x2 lo = *(const LAS u32x2*)(qrow + (32 * db + 16 * ks + 4 * hh) * 2), hi = *(const LAS u32x2*)(qrow + (32 * db + 16 * ks + 8 + 4 * hh) * 2);
                    const bf16x8 qa = __builtin_bit_cast(bf16x8, (u32x4){lo.x, lo.y, hi.x, hi.y}); O = MFMA32(qa, sb, O); }
        }
#pragma unroll
        for (int ks = 0; ks < 2; ++ks) { const bf16x8 vb2 = *(const LAS bf16x8*)(vrow + (16 * ks + 8 * hh) * 2);
#pragma unroll
            for (int db = 0; db < 4; ++db) { const bf16x8 ka = *(const LAS bf16x8*)(L + HG_KTT + (32 * db + r32) * HG_TP + (16 * ks + 8 * hh) * 2); S[db] = MFMA32(ka, vb2, S[db]); } }
#pragma unroll
        for (int db = 0; db < 4; ++db)
#pragma unroll
            for (int g = 0; g < 4; ++g) { const f32x4 f4 = *(const LAS f32x4*)(L + HG_SB + (32 * db + 8 * g + 4 * hh) * 4);
#pragma unroll
                for (int cc = 0; cc < 4; ++cc) S[db][4 * g + cc] *= f4[cc]; }
        if (PASS_C) { LAS unsigned char* ot = F.lds + HG_OT_OFF + dir * 8192 + (32 * w + r32) * 2;
#pragma unroll
            for (int i = 0; i < 16; ++i) *(LAS unsigned short*)(ot + crow(i, hh) * 256) = (unsigned short)f2bf(O[i]); }
        asm volatile("s_waitcnt vmcnt(0)" ::: "memory");
        HG_LDS_BARRIER();
        if (PASS_C) { bf16_t* od = WSP(bf16_t, WS_ODIR) + ((size_t)dir * M + (size_t)(b * SEQ)) * 512 + hd * 128;
#pragma unroll
            for (int k2 = 0; k2 < 2; ++k2) { const int pc = ltid + 256 * k2, rw = pc >> 4, ch = pc & 15;
                const u32x4 v4 = *(const LAS u32x4*)(F.lds + HG_OT_OFF + dir * 8192 + rw * 256 + ch * 16);
                *(u32x4*)(od + (size_t)(tbase + tstep * (32 * sc + rw)) * 512 + ch * 8) = v4; } }
    }
#undef HG_DMA
    if (!PASS_C) { f32x4* sl = (f32x4*)(WSP(float, WS_SLOC) + (size_t)udir * 16384) + (w * 16) * 64 + lane;
#pragma unroll
        for (int db = 0; db < 4; ++db)
#pragma unroll
            for (int g = 0; g < 4; ++g) sl[(db * 4 + g) * 64] = (f32x4){S[db][4 * g], S[db][4 * g + 1], S[db][4 * g + 2], S[db][4 * g + 3]};
        *(LAS float*)(L + HG_DS + (hf * 128 + c) * 4) = lsum;
        __syncthreads();
        if (hf == 0) WSP(float, WS_DEC)[udir * 128 + c] = __expf(*(const LAS float*)(L + HG_DS + c * 4) + *(const LAS float*)(L + HG_DS + (128 + c) * 4));
        __syncthreads();
    }
}
__device__ __forceinline__ void conv_phase(Frame& F) {
    const bf16_t* P = WSP(const bf16_t, WS_PROJ); bf16_t* YA = WSP(bf16_t, WS_YAB);
    const int nthr = F.G * NWAVES * 64;
    const u32x4 zero4 = {0u, 0u, 0u, 0u};
    for (int it0 = F.vcu * (NWAVES * 64) + F.tid; it0 < M * (CD / 8); it0 += 4 * nthr) {
        u32x4 cb[4], cc[4], ch[4], ccp[4], chp[4], ccn[4], chn[4];
#pragma unroll
        for (int q = 0; q < 4; ++q) { const int it = it0 + q * nthr; if (it < M * (CD / 8)) { const int t = it >> 6, c8 = (it & 63) * 8, l = t & (SEQ - 1); const size_t row = (size_t)t * NIN;
            cb[q] = *(const u32x4*)(P + row + C_CB + c8); cc[q] = *(const u32x4*)(P + row + C_CC + c8); ch[q] = *(const u32x4*)(P + row + C_CH + c8);
            ccp[q] = zero4; chp[q] = zero4; ccn[q] = zero4; chn[q] = zero4;
            if (l > 0) { ccp[q] = *(const u32x4*)(P + row - NIN + C_CC + c8); chp[q] = *(const u32x4*)(P + row - NIN + C_CH + c8); }
            if (l < SEQ - 1) { ccn[q] = *(const u32x4*)(P + row + NIN + C_CC + c8); chn[q] = *(const u32x4*)(P + row + NIN + C_CH + c8); } } }
#pragma unroll
        for (int q = 0; q < 4; ++q) { const int it = it0 + q * nthr; if (it < M * (CD / 8)) { const int t = it >> 6, c8 = (it & 63) * 8;
            const f32x4 w0a = *(const f32x4*)(F.conv_w + c8), w0b = *(const f32x4*)(F.conv_w + c8 + 4), w1a = *(const f32x4*)(F.conv_w + CD + c8), w1b = *(const f32x4*)(F.conv_w + CD + c8 + 4),
                        w2a = *(const f32x4*)(F.conv_w + 2 * CD + c8), w2b = *(const f32x4*)(F.conv_w + 2 * CD + c8 + 4);
            float r[8];
#pragma unroll
            for (int p = 0; p < 4; ++p) {
                const float w0l = p < 2 ? w0a[2 * p] : w0b[2 * p - 4], w0h = p < 2 ? w0a[2 * p + 1] : w0b[2 * p - 3];
                const float w1l = p < 2 ? w1a[2 * p] : w1b[2 * p - 4], w1h = p < 2 ? w1a[2 * p + 1] : w1b[2 * p - 3];
                const float w2l = p < 2 ? w2a[2 * p] : w2b[2 * p - 4], w2h = p < 2 ? w2a[2 * p + 1] : w2b[2 * p - 3];
                r[2 * p]     = bflo(cb[q][p]) * (w0l * (bflo(ccp[q][p]) * bflo(chp[q][p])) + w1l * (bflo(cc[q][p]) * bflo(ch[q][p])) + w2l * (bflo(ccn[q][p]) * bflo(chn[q][p])));
                r[2 * p + 1] = bfhi(cb[q][p]) * (w0h * (bfhi(ccp[q][p]) * bfhi(chp[q][p])) + w1h * (bfhi(cc[q][p]) * bfhi(ch[q][p])) + w2h * (bfhi(ccn[q][p]) * bfhi(chn[q][p])));
            }
            u32x4 o; o.x = pk2(r[0], r[1]); o.y = pk2(r[2], r[3]); o.z = pk2(r[4], r[5]); o.w = pk2(r[6], r[7]);
            *(u32x4*)(YA + (size_t)t * D + c8) = o; } }
    }
}
__device__ __forceinline__ void scan_phase(Frame& F) {
    const float* SL = WSP(const float, WS_SLOC); const float* DEC = WSP(const float, WS_DEC); float* SI = WSP(float, WS_SLOC);
    const int nthr = F.G * NWAVES * 64;
    for (int idx4 = F.vcu * (NWAVES * 64) + F.tid; idx4 < 32 * 4096; idx4 += nthr) {
        const int seq = idx4 >> 12, de = (idx4 & 4095) * 4, d0 = 32 * ((de >> 10) & 3) + 8 * ((de >> 8) & 3) + 4 * ((de >> 7) & 1);
        f32x4 sl[NSC], dc[NSC];
#pragma unroll
        for (int j = 0; j < NSC; ++j) { const int unit = seq * NSC + j; sl[j] = *(const f32x4*)(SL + (size_t)unit * 16384 + de); dc[j] = *(const f32x4*)(DEC + unit * 128 + d0); }
        asm volatile("s_waitcnt vmcnt(0)" ::: "memory");
        f32x4 Ecur = {0.f, 0.f, 0.f, 0.f};
#pragma unroll
        for (int j = 0; j < NSC; ++j) { const int unit = seq * NSC + j; *(f32x4*)(SI + (size_t)unit * 16384 + de) = Ecur; Ecur = dc[j] * Ecur + sl[j]; }
    }
}
__device__ __forceinline__ void rms_unit(Frame& F, int unit) {
    const int j = unit & 15, hd = (unit >> 4) & 3, b = unit >> 6;
    const bf16_t* O0 = WSP(const bf16_t, WS_ODIR); const bf16_t* O1 = O0 + (size_t)M * 512; const bf16_t* P = WSP(const bf16_t, WS_PROJ); bf16_t* YB = WSP(bf16_t, WS_YAB) + CD;
    asm volatile("s_waitcnt vmcnt(0)" ::: "memory");
    __syncthreads();
    const f32x4 nw = *(const f32x4*)(F.norm_w + hd * 128 + (F.tid & 31) * 4);
    for (int it0 = F.tid; it0 < SC * 32; it0 += 8 * NWAVES * 64) {
        u32x2 oa[8], ob[8]; u32x2 gg[8];
#pragma unroll
        for (int q = 0; q < 8; ++q) { const int it = it0 + q * (NWAVES * 64); const int t = b * SEQ + j * SC + (it >> 5), l4 = (it & 31) * 4; const size_t off = (size_t)t * 512 + hd * 128 + l4;
            oa[q] = *(const u32x2*)(O0 + off); ob[q] = *(const u32x2*)(O1 + off); gg[q] = *(const u32x2*)(P + (size_t)t * NIN + C_G + hd * 128 + l4); }
#pragma unroll
        for (int q = 0; q < 8; ++q) { const int it = it0 + q * (NWAVES * 64); const int t = b * SEQ + j * SC + (it >> 5), l4 = (it & 31) * 4;
            const f32x4 o = (f32x4){bflo(oa[q].x) + bflo(ob[q].x), bfhi(oa[q].x) + bfhi(ob[q].x), bflo(oa[q].y) + bflo(ob[q].y), bfhi(oa[q].y) + bfhi(ob[q].y)};
            float ss = (o[0] * o[0] + o[1] * o[1]) + (o[2] * o[2] + o[3] * o[3]);
#pragma unroll
            for (int s2 = 1; s2 < 32; s2 <<= 1) ss += __shfl_xor(ss, s2);
            const float rs = 1.0f / sqrtf(ss * (1.0f / 128.0f) + RMS_EPS);
            const u32x2 g = gg[q];
            u32x2 w; w.x = pk2(o[0] * rs * nw[0] * bflo(g.x), o[1] * rs * nw[1] * bfhi(g.x)); w.y = pk2(o[2] * rs * nw[2] * bflo(g.y), o[3] * rs * nw[3] * bfhi(g.y));
            *(u32x2*)(YB + (size_t)t * D + hd * 128 + l4) = w; }
    }
}

constexpr int WRT_STRIDE = 1028;
__device__ __forceinline__ void transpose_reduce32(float (&vals)[32], int lane) {
#pragma unroll
    for (int s = 0; s < 5; ++s) { const int half = 16 >> s; const bool up = (lane & half) != 0;
#pragma unroll
        for (int k = 0; k < half; ++k) { const float a = vals[k], b = vals[k + half]; const float keep = up ? b : a, send = up ? a : b; vals[k] = keep + __shfl_xor(send, half); } }
    vals[0] += __shfl_xor(vals[0], 32);
}
__device__ __forceinline__ void ln1_router_phase(Frame& F) {
    LAS float* wrT = (LAS float*)F.lds;
    LAS unsigned* cnt = (LAS unsigned*)(F.lds + 32 * WRT_STRIDE * 4);
    { f32x4 wv[16];
#pragma unroll
      for (int q = 0; q < 16; ++q) wv[q] = *(const f32x4*)(F.w_router + 4 * (F.tid + q * (NWAVES * 64)));
#pragma unroll
      for (int q = 0; q < 16; ++q) { const int i4 = F.tid + q * (NWAVES * 64), c = i4 >> 3, e0 = (i4 & 7) * 4;
#pragma unroll
          for (int i = 0; i < 4; ++i) wrT[(e0 + i) * WRT_STRIDE + c] = wv[q][i]; } }
    const bf16_t* OUTB = WSP(const bf16_t, WS_Z); bf16_t* HF = WSP(bf16_t, WS_HF); unsigned char* HQ = WSP(unsigned char, WS_HB);
    int* TOPI = WSP(int, WS_TOPI); float* TOPG = WSP(float, WS_TOPG); int* BLKCNT = WSP(int, WS_BLKCNT);
    const int lane = F.lane, e8 = lane & 7;
    float brv[4];
#pragma unroll
    for (int ch = 0; ch < 4; ++ch) brv[ch] = F.b_router[8 * ch + e8];
    for (int rb = blockIdx.x; rb < M / 64; rb += F.G) {
        { const int l2 = fresh_lane(); if (F.wave == 0 && l2 < 32) cnt[l2] = 0u; }
        __syncthreads();
        for (int g = 0; g < 2; ++g) {
            const int row0 = rb * 64 + F.wave * 8 + 4 * g;
            f32x4 gv[4], bv[4];
            { unsigned go = (unsigned)lane * 16u; asm volatile("" : "+v"(go));
#pragma unroll
              for (int j = 0; j < 4; ++j) { gv[j] = *(const f32x4*)((const char*)F.ln1_g + go + 1024 * j); bv[j] = *(const f32x4*)((const char*)F.ln1_b + go + 1024 * j); } }
            f32x4 v[4][4];
            u32x2 ob[4][4];
#pragma unroll
            for (int q = 0; q < 4; ++q) { const f32x4* xr = (const f32x4*)(F.x + (size_t)(row0 + q) * D) + lane; const u32x2* orow = (const u32x2*)(OUTB + (size_t)(row0 + q) * D) + lane;
#pragma unroll
                for (int j = 0; j < 4; ++j) { v[q][j] = __builtin_nontemporal_load(xr + 64 * j); ob[q][j] = __builtin_nontemporal_load(orow + 64 * j); } }
#pragma unroll
            for (int q = 0; q < 4; ++q)
#pragma unroll
                for (int j = 0; j < 4; ++j) { v[q][j] = v[q][j] * DN_ALPHA; v[q][j][0] += bflo(ob[q][j].x); v[q][j][1] += bfhi(ob[q][j].x); v[q][j][2] += bflo(ob[q][j].y); v[q][j][3] += bfhi(ob[q][j].y); }
#pragma unroll
            for (int q = 0; q < 4; ++q) { float s = 0.f;
#pragma unroll
                for (int j = 0; j < 4; ++j) s += (v[q][j][0] + v[q][j][1]) + (v[q][j][2] + v[q][j][3]);
                const float mean = wave_sum(s) * (1.f / D); float s2 = 0.f;
#pragma unroll
                for (int j = 0; j < 4; ++j) { v[q][j] = v[q][j] - mean; s2 += (v[q][j][0] * v[q][j][0] + v[q][j][1] * v[q][j][1]) + (v[q][j][2] * v[q][j][2] + v[q][j][3] * v[q][j][3]); }
                const float rstd = 1.f / sqrtf(wave_sum(s2) * (1.f / D) + LN_EPS);
                u32x2* hr = (u32x2*)(HF + (size_t)(row0 + q) * D) + lane; unsigned* hq4 = (unsigned*)(HQ + (size_t)(row0 + q) * D) + lane;
#pragma unroll
                for (int j = 0; j < 4; ++j) { v[q][j] = v[q][j] * rstd * gv[j] + bv[j]; hr[64 * j] = (u32x2){pk2(v[q][j][0], v[q][j][1]), pk2(v[q][j][2], v[q][j][3])};
                    hq4[64 * j] = pk4_fp8(v[q][j][0] * Q_SH, v[q][j][1] * Q_SH, v[q][j][2] * Q_SH, v[q][j][3] * Q_SH); } }
            float lg[4];
#pragma unroll
            for (int ch = 0; ch < 4; ++ch) { float p[32];
#pragma unroll
                for (int e2 = 0; e2 < 8; ++e2) { f32x4 w[4];
#pragma unroll
                    for (int j = 0; j < 4; ++j) w[j] = *(const LAS f32x4*)(wrT + (8 * ch + e2) * WRT_STRIDE + 4 * lane + 256 * j);
#pragma unroll
                    for (int q = 0; q < 4; ++q) { f32x2 a2 = {0.f, 0.f};
#pragma unroll
                        for (int j = 0; j < 4; ++j) { a2 = __builtin_elementwise_fma((f32x2){v[q][j][0], v[q][j][1]}, (f32x2){w[j][0], w[j][1]}, a2); a2 = __builtin_elementwise_fma((f32x2){v[q][j][2], v[q][j][3]}, (f32x2){w[j][2], w[j][3]}, a2); }
                        p[q * 8 + e2] = a2.x + a2.y; } }
                transpose_reduce32(p, lane);
                lg[ch] = p[0] + brv[ch]; }
            float tv[TOPK]; int ti[TOPK];
#pragma unroll
            for (int k = 0; k < TOPK; ++k) { float bvv = lg[0]; int bi = e8;
#pragma unroll
                for (int ch = 1; ch < 4; ++ch) if (lg[ch] > bvv) { bvv = lg[ch]; bi = 8 * ch + e8; }
#pragma unroll
                for (int o = 1; o < 8; o <<= 1) { const float ov = __shfl_xor(bvv, o); const int oi = __shfl_xor(bi, o); const bool take = (ov > bvv) || (ov == bvv && oi < bi); bvv = take ? ov : bvv; bi = take ? oi : bi; }
                tv[k] = bvv; ti[k] = bi;
#pragma unroll
                for (int ch = 0; ch < 4; ++ch) if (bi == 8 * ch + e8) lg[ch] = -3.0e38f; }
            float ex[TOPK], se = 0.f;
#pragma unroll
            for (int k = 0; k < TOPK; ++k) { ex[k] = __expf(tv[k] - tv[0]); se += ex[k]; }
            const float inv = 1.0f / se;
            const int l3 = fresh_lane(), e8w = l3 & 7, rqw = (l3 & 31) >> 3;
            if (l3 < 32 && e8w < TOPK) { int myi = ti[0]; float myg = ex[0];
#pragma unroll
                for (int k = 1; k < TOPK; ++k) if (e8w == k) { myi = ti[k]; myg = ex[k]; }
                const int row = row0 + rqw;
                TOPI[row * TOPK + e8w] = myi; TOPG[row * TOPK + e8w] = myg * inv; __hip_atomic_fetch_add(&cnt[myi], 1u, __ATOMIC_RELAXED, __HIP_MEMORY_SCOPE_WORKGROUP); }
        }
        __syncthreads();
        { const int l2 = fresh_lane(); if (F.wave == 0 && l2 < 32) BLKCNT[rb * 32 + l2] = (int)cnt[l2]; }
        __syncthreads();
    }
}

__device__ __forceinline__ void routing_phase(Frame& F) {
    LAS int* ptot = (LAS int*)F.lds;
    LAS int* plo = ptot + 512;
    LAS int* tot = plo + 512;
    LAS int* lo = tot + 32;
    LAS int* startL = lo + 32;
    LAS int* baseL = startL + 64;
    LAS unsigned* cursor = (LAS unsigned*)(baseL + 32);
    const int* BLKCNT = WSP(const int, WS_BLKCNT); const int* TOPI = WSP(const int, WS_TOPI); const float* TOPG = WSP(const float, WS_TOPG);
    int* POSOF = WSP(int, WS_POSOF); int* SLOTTOK = WSP(int, WS_SLOTTOK); float* SLOTGATE = WSP(float, WS_SLOTGATE); int* META = WSP(int, WS_META);
    const int tid = F.tid;
    for (int rb = blockIdx.x; rb < M / 64; rb += F.G) {
        { const int part = tid >> 5, e = tid & 31; int st = 0, sl = 0;
            for (int b2 = part * 16; b2 < part * 16 + 16; ++b2) { const int c = BLKCNT[b2 * 32 + e]; st += c; if (b2 < rb) sl += c; }
            ptot[part * 32 + e] = st; plo[part * 32 + e] = sl; }
        __syncthreads();
        if (tid < 32) { int st = 0, sl = 0;
            for (int p = 0; p < 16; ++p) { st += ptot[p * 32 + tid]; sl += plo[p * 32 + tid]; }
            tot[tid] = st; lo[tid] = sl; }
        __syncthreads();
        if (tid < 33) { int s = 0;
            for (int e2 = 0; e2 < tid; ++e2) s += (tot[e2] + 255) & ~255;
            startL[tid] = s; if (tid < 32) { baseL[tid] = s + lo[tid]; cursor[tid] = 0u; } }
        __syncthreads();
        if (tid < 256) { const int t = rb * 64 + (tid >> 2), k = tid & 3; const int e = TOPI[t * TOPK + k]; const float g = TOPG[t * TOPK + k];
            const unsigned r = __hip_atomic_fetch_add(&cursor[e], 1u, __ATOMIC_RELAXED, __HIP_MEMORY_SCOPE_WORKGROUP); const int pos = baseL[e] + (int)r;
            SLOTTOK[pos] = t; SLOTGATE[pos] = g; POSOF[t * TOPK + k] = pos; }
        if (rb < NE) { const int e = rb; const int p0 = startL[e] + tot[e], p1 = startL[e + 1];
            for (int p = p0 + tid; p < p1; p += NWAVES * 64) { SLOTTOK[p] = 0; SLOTGATE[p] = 0.f; } }
        if (rb == 0 && tid < 33) META[tid] = startL[tid] >> 8;
        __syncthreads();
    }
}

__device__ __forceinline__ void final_phase(Frame& F) {
    const bf16_t* HF = WSP(const bf16_t, WS_HF); const unsigned char* Y = WSP(const unsigned char, WS_Y); const int* POSOF = WSP(const int, WS_POSOF);
    const int gw = F.vcu * NWAVES + F.wave, NGW = F.G * NWAVES, lane = F.lane;
    f32x4 gv[4], bv[4];
#pragma unroll
    for (int j = 0; j < 4; ++j) { gv[j] = *(const f32x4*)(F.ln2_g + 4 * lane + 256 * j); bv[j] = *(const f32x4*)(F.ln2_b + 4 * lane + 256 * j); }
    const int nit = (M - gw + NGW - 1) / NGW;
    for (int base = 0; base < nit; base += 8) {
        int pv = 0; { const int it = base + (lane >> 2); if (lane < 32 && it < nit) pv = POSOF[(gw + it * NGW) * TOPK + (lane & 3)]; }
        for (int i2 = 0; i2 < 8 && base + i2 < nit; i2 += 2) {
            const bool two = (base + i2 + 1 < nit);
            const int rowA = gw + (base + i2) * NGW, rowB = two ? rowA + NGW : rowA;
            f32x4 va[4], vb[4]; unsigned ya[4][4], yb[4][4];
            { const u32x2* ha = (const u32x2*)(HF + (size_t)rowA * D) + lane; const u32x2* hb = (const u32x2*)(HF + (size_t)rowB * D) + lane;
#pragma unroll
              for (int j = 0; j < 4; ++j) { const u32x2 a = __builtin_nontemporal_load(ha + 64 * j), b2 = __builtin_nontemporal_load(hb + 64 * j); va[j] = (f32x4){bflo(a.x), bfhi(a.x), bflo(a.y), bfhi(a.y)}; vb[j] = (f32x4){bflo(b2.x), bfhi(b2.x), bflo(b2.y), bfhi(b2.y)}; } }
#pragma unroll
            for (int k = 0; k < TOPK; ++k) { const int pa = __builtin_amdgcn_readlane(pv, i2 * 4 + k), pb = __builtin_amdgcn_readlane(pv, (two ? i2 + 1 : i2) * 4 + k);
                const unsigned* ra = (const unsigned*)(Y + (size_t)pa * D) + lane; const unsigned* rb = (const unsigned*)(Y + (size_t)pb * D) + lane;
#pragma unroll
                for (int j = 0; j < 4; ++j) { ya[k][j] = __builtin_nontemporal_load(ra + 64 * j); yb[k][j] = __builtin_nontemporal_load(rb + 64 * j); } }
#pragma unroll
            for (int r = 0; r < 2; ++r) {
                f32x4 v[4];
#pragma unroll
                for (int j = 0; j < 4; ++j) { v[j] = (r ? vb[j] : va[j]) * DN_ALPHA;
#pragma unroll
                    for (int k = 0; k < TOPK; ++k) { const unsigned w = r ? yb[k][j] : ya[k][j]; const f32x2 lo = __builtin_amdgcn_cvt_pk_f32_fp8((int)w, false), hi = __builtin_amdgcn_cvt_pk_f32_fp8((int)w, true);
                        v[j][0] += lo.x * (1.0f / Q_SY); v[j][1] += lo.y * (1.0f / Q_SY); v[j][2] += hi.x * (1.0f / Q_SY); v[j][3] += hi.y * (1.0f / Q_SY); } }
                float s = 0.f;
#pragma unroll
                for (int j = 0; j < 4; ++j) s += (v[j][0] + v[j][1]) + (v[j][2] + v[j][3]);
                const float mean = wave_sum(s) * (1.f / D); float s2 = 0.f;
#pragma unroll
                for (int j = 0; j < 4; ++j) { v[j] = v[j] - mean; s2 += (v[j][0] * v[j][0] + v[j][1] * v[j][1]) + (v[j][2] * v[j][2] + v[j][3] * v[j][3]); }
                const float rstd = 1.f / sqrtf(wave_sum(s2) * (1.f / D) + LN_EPS);
                if (r == 0 || two) { f32x4* orow = (f32x4*)(F.out + (size_t)(r ? rowB : rowA) * D) + lane;
#pragma unroll
                    for (int j = 0; j < 4; ++j) __builtin_nontemporal_store(v[j] * rstd * gv[j] + bv[j], orow + 64 * j); }
            }
        }
    }
}

constexpr int NPH = 12;
constexpr int N_LAUNCHES = MK_N_LAUNCHES;
struct Args { const float* in[18]; float* out; unsigned char* ws; int ph_lo, ph_hi; };
__global__ void __launch_bounds__(NWAVES * 64, 2) skel_fwd(Args args) {
    extern __shared__ __attribute__((aligned(16))) unsigned char lds[];
    Frame F;
    F.lds = (LAS unsigned char*)lds;
    F.MISC = (volatile LAS unsigned*)(F.lds + MISC_OFF);
    F.tid = threadIdx.x; F.lane = F.tid & 63; F.wave = __builtin_amdgcn_readfirstlane(F.tid >> 6);
    F.G = gridDim.x; { const int bx = blockIdx.x; F.vcu = (F.G % 8 == 0) ? (bx % 8) * (F.G / 8) + bx / 8 : bx; }
    F.ws = args.ws; F.ctl = (gu32*)(args.ws + WS_CTL); F.out = args.out;
    F.x = args.in[0]; F.w_in = args.in[1]; F.conv_w = args.in[2]; F.p_a = args.in[3]; F.lb_logits = args.in[4]; F.norm_w = args.in[5]; F.p_b = args.in[6]; F.w_o = args.in[7];
    F.ln1_g = args.in[8]; F.ln1_b = args.in[9]; F.w_router = args.in[10]; F.b_router = args.in[11]; F.w1 = args.in[12]; F.b1 = args.in[13]; F.w2 = args.in[14]; F.b2 = args.in[15];
    F.ln2_g = args.in[16]; F.ln2_b = args.in[17];
    if (F.tid < 32) F.MISC[F.tid] = 0u;
    __syncthreads();
    XcdBarrier bar; bar.bar = (unsigned*)(F.ctl + CW_BAR); bar.x = 0; bar.st = nullptr;
    if (N_LAUNCHES != NPH) bar = xcd_barrier_post((unsigned*)(F.ctl + CW_BAR), F.MISC + 8, F.tid == 0);
#define GRID_BAR() do { if (N_LAUNCHES != NPH) xcd_barrier(bar, F.wave == 0 && fresh_lane() == 0); } while (0)
    const int lo = args.ph_lo, hi = args.ph_hi;
#define IN(k) (lo <= (k) && (k) < hi && (F.lane = fresh_lane(), F.tid = F.wave * 64 + F.lane, true))
#define BOTH(k) (IN(k) && IN((k) + 1))
#define REP(k) for (int rep_ = 0; rep_ < 1 + ((PROBE_DUP_MASK >> (k)) & 1); ++rep_)
    LAS unsigned* tokbuf = (LAS unsigned*)(F.lds + TOKBUF_OFF);
    LAS int* moets = (LAS int*)(F.lds + MOETS_OFF);

    if (IN(0)) { REP(0) p0_prologue<0>(F); if (BOTH(0)) GRID_BAR(); }
    if (IN(1)) {
        REP(1) {
        pg8::StaticOrder S; S.init(WSP(char, WS_XB), WSP(char, WS_WIN), M, NIN, D, F.G, (int)blockIdx.x);
        pg8::EpiProj E{WSP(bf16_t, WS_PROJ), WSP(const float, WS_LB)};
        pg8::gemm_phase<false, true, false>(F.lds, tokbuf, nullptr, D, S, E, F.wave);
        }
        if (BOTH(1)) GRID_BAR();
    }
    if (IN(2)) {
        REP(2) { for (int u = F.vcu; u < NB * NH * NSC; u += F.G) hgrn_mfma_unit<false>(F, u);
        conv_phase(F); }
        if (BOTH(2)) GRID_BAR();
    }
    if (IN(3)) { REP(3) scan_phase(F); if (BOTH(3)) GRID_BAR(); }
    if (IN(4)) {
        REP(4) { for (int u = F.vcu; u < NB * NH * NSC; u += F.G) { hgrn_mfma_unit<true>(F, u); rms_unit(F, u); } }
        if (BOTH(4)) GRID_BAR();
    }
    if (IN(5)) {
        REP(5) {
        pg8::StaticOrder S; S.init(WSP(char, WS_YAB), WSP(char, WS_PAB), M, D, D, F.G, (int)blockIdx.x);
        pg8::EpiMix E{WSP(const bf16_t, WS_PROJ), WSP(bf16_t, WS_MIX)};
        pg8::gemm_phase<false, false, false>(F.lds, tokbuf, nullptr, D, S, E, F.wave);
        }
        if (BOTH(5)) GRID_BAR();
    }
    if (IN(6)) {
        REP(6) {
        pg8::StaticOrder S; S.init(WSP(char, WS_MIX), WSP(char, WS_WO), M, D, D, F.G, (int)blockIdx.x);
        pg8::EpiResid E{WSP(bf16_t, WS_Z)};
        pg8::gemm_phase<false, false, false>(F.lds, tokbuf, nullptr, D, S, E, F.wave);
        }
        if (BOTH(6)) GRID_BAR();
    }
    if (IN(7)) { REP(7) ln1_router_phase(F); if (BOTH(7)) GRID_BAR(); }
    if (IN(8)) { REP(8) { routing_phase(F); __syncthreads(); p0_prologue<1>(F); } if (BOTH(8)) GRID_BAR(); }
    if (IN(9)) {
        if (F.tid < 33) moets[F.tid] = WSP(const int, WS_META)[F.tid];
        __syncthreads();
        REP(9) {
        pg8::MoeOrder S{WSP(const char, WS_HB), WSP(const char, WS_W1), D / 2, 8, F.G, (int)blockIdx.x, moets, true};
        pg8::EpiSwiglu E{WSP(unsigned char, WS_ACT), F.b1};
        pg8::gemm_phase<true, true, true>(F.lds, tokbuf, WSP(const int, WS_SLOTTOK), D / 2, S, E, F.wave);
        }
        if (BOTH(9)) GRID_BAR();
    }
    if (IN(10)) {
        if (F.tid < 33) moets[F.tid] = WSP(const int, WS_META)[F.tid];
        __syncthreads();
        REP(10) {
        pg8::MoeOrder S{WSP(const char, WS_ACT), WSP(const char, WS_W2), DFF / 2, 4, F.G, (int)blockIdx.x, moets, false};
        pg8::EpiMoeOut E{WSP(unsigned char, WS_Y), F.b2, WSP(const float, WS_SLOTGATE)};
        pg8::gemm_phase<false, true, true>(F.lds, tokbuf, nullptr, DFF / 2, S, E, F.wave);
        }
        if (BOTH(10)) GRID_BAR();
    }
    if (IN(11)) { REP(11) final_phase(F); }
#undef IN
#undef BOTH
}

extern "C" void kernel_launch(void* const* d_in, const int* in_sizes, int n_in, void* d_out, int out_size, void* d_ws, size_t ws_size, hipStream_t stream) {
    static int grid = 0;
    if (grid == 0) {
        if (n_in != 18 || in_sizes[0] != M * D || out_size != M * D || ws_size < WS_END) { fprintf(stderr, "kernel_launch: unexpected shapes / workspace (n_in %d, ws %zu)\n", n_in, ws_size); grid = -1; return; }
        int dev = 0, cus = 0, per_cu = 0;
        if (hipGetDevice(&dev) != hipSuccess || hipDeviceGetAttribute(&cus, hipDeviceAttributeMultiprocessorCount, dev) != hipSuccess) { grid = -1; return; }
        if (hipFuncSetAttribute((const void*)skel_fwd, hipFuncAttributeMaxDynamicSharedMemorySize, LDS_BYTES) != hipSuccess) { fprintf(stderr, "kernel_launch: hipFuncSetAttribute failed\n"); grid = -1; return; }
        if (hipOccupancyMaxActiveBlocksPerMultiprocessor(&per_cu, (const void*)skel_fwd, NWAVES * 64, LDS_BYTES) != hipSuccess || per_cu < 1)
            fprintf(stderr, "kernel_launch: note: occupancy query reports %d workgroups per CU\n", per_cu);
        (void)hipGetLastError();
        grid = cus;
    }
    if (grid < 0) return;
    if (hipMemsetAsync((char*)d_ws + WS_CTL, 0, CTL_ZERO_BYTES, stream) != hipSuccess) return;
    Args a{};
    for (int i = 0; i < 18; ++i) a.in[i] = (const float*)d_in[i];
    a.out = (float*)d_out; a.ws = (unsigned char*)d_ws;
    if (N_LAUNCHES == 1) { a.ph_lo = 0; a.ph_hi = NPH; hipLaunchKernelGGL(skel_fwd, dim3(grid), dim3(NWAVES * 64), LDS_BYTES, stream, a); }
    else { for (int p = 0; p < NPH; ++p) { a.ph_lo = p; a.ph_hi = p + 1; hipLaunchKernelGGL(skel_fwd, dim3(grid), dim3(NWAVES * 64), LDS_BYTES, stream, a); } }
}
```

```cpp
#include <hip/hip_runtime.h>
#include <cstdio>
#include <cstdint>

#ifndef MK_N_LAUNCHES
#define MK_N_LAUNCHES 1
#endif

#ifndef PROBE_DUP_MASK
#define PROBE_DUP_MASK 0
#endif
#define LAS __attribute__((address_space(3)))
#define GAS __attribute__((address_space(1)))
typedef unsigned short bf16_t;
typedef short bf16x8 __attribute__((ext_vector_type(8)));
typedef float f32x4 __attribute__((ext_vector_type(4)));
typedef float f32x2 __attribute__((ext_vector_type(2)));
typedef unsigned u32x4 __attribute__((ext_vector_type(4)));
typedef unsigned u32x2 __attribute__((ext_vector_type(2)));
typedef GAS unsigned gu32;

constexpr int NB = 4, SEQ = 4096, M = NB * SEQ, D = 1024, NIN = 6144, CD = 512, NH = 4, DKH = 128, NE = 32, TOPK = 4, DFF = 1024;
constexpr int C_CB = 0, C_CC = 512, C_CH = 1024, C_Q = 1536, C_FF = 2048, C_FB = 2560, C_V = 3072, C_G = 3584, C_GA = 4096, C_GB = 5120;
constexpr float DN_ALPHA = 1.189207115002721f, LN_EPS = 1e-5f, RMS_EPS = 1e-6f, SW_ALPHA = 1.702f, SW_LIMIT = 7.0f;
constexpr int NSLOT = M * TOPK + NE * 256;
constexpr int SC = 256, NSC = SEQ / SC;
constexpr int NUNIT_H = NB * NH * 2 * NSC;

constexpr size_t MiB = 1u << 20;
constexpr size_t WS_CTL = 0, CTL_ZERO_BYTES = 128 * 1024;
constexpr size_t WS_LB = 1 * MiB;
constexpr size_t WS_BLKCNT = 1 * MiB + 16 * 1024;
constexpr size_t WS_META = 1 * MiB + 64 * 1024;
constexpr size_t WS_TOPI = 1 * MiB + 128 * 1024;
constexpr size_t WS_TOPG = 1 * MiB + 384 * 1024;
constexpr size_t WS_POSOF = 1 * MiB + 640 * 1024;
constexpr size_t WS_SLOTTOK = 2 * MiB;
constexpr size_t WS_SLOTGATE = 2 * MiB + 512 * 1024;
constexpr size_t WS_DEC = 3 * MiB;
constexpr size_t WS_WIN = 4 * MiB;
constexpr size_t WS_PAB = 16 * MiB;
constexpr size_t WS_WO = 18 * MiB;
constexpr size_t WS_W1 = 20 * MiB;
constexpr size_t WS_W2 = 148 * MiB;
constexpr size_t WS_PROJ = 212 * MiB;
constexpr size_t WS_ACT = 212 * MiB;
constexpr size_t WS_XB = 404 * MiB;
constexpr size_t WS_YAB = 436 * MiB;
constexpr size_t WS_T1 = 468 * MiB;
constexpr size_t WS_MIX = 532 * MiB;
constexpr size_t WS_Y = 404 * MiB;
constexpr size_t WS_Z = 480 * MiB;
constexpr size_t WS_ODIR = 564 * MiB;
constexpr size_t WS_HF = 628 * MiB;
constexpr size_t WS_HB = 692 * MiB;
constexpr size_t WS_SLOC = 724 * MiB;
constexpr size_t WS_XQ = 756 * MiB;
constexpr size_t WS_WINQ = 772 * MiB;
constexpr size_t WS_END = 788 * MiB;
static_assert(WS_Y + (size_t)NSLOT * 1024 <= WS_Z && WS_Z + (size_t)M * D * 2 <= WS_MIX && WS_ACT + (size_t)NSLOT * 1024 * 2 <= WS_XB, "overlay map");

constexpr int CW_BAR = 4096;
constexpr int CW_GRP = 16384, CW_GX = 24576;

constexpr int RING_BYTES = 131072;
constexpr int LDS_BYTES = 163840;
constexpr int HG_OT_OFF = RING_BYTES;
constexpr int TOKBUF_OFF = LDS_BYTES - 4096;
constexpr int MOETS_OFF = TOKBUF_OFF + 2048;
constexpr int MISC_OFF = MOETS_OFF + 256;
static_assert(HG_OT_OFF + 16384 <= TOKBUF_OFF && MISC_OFF + 128 <= LDS_BYTES, "LDS map");
constexpr int NWAVES = 8;

__device__ __forceinline__ float bf2f(unsigned b) { return __uint_as_float(b << 16); }
__device__ __forceinline__ float bflo(unsigned w) { return __uint_as_float(w << 16); }
__device__ __forceinline__ float bfhi(unsigned w) { return __uint_as_float(w & 0xffff0000u); }
__device__ __forceinline__ unsigned f2bf(float f) { unsigned u = __float_as_uint(f); return (u + 0x7fffu + ((u >> 16) & 1u)) >> 16; }
__device__ __forceinline__ unsigned pk2(float lo, float hi) { return f2bf(lo) | (f2bf(hi) << 16); }
__device__ __forceinline__ float sigmoidf_(float x) { return __builtin_amdgcn_rcpf(1.0f + __expf(-x)); }
constexpr float Q_SX = 16.0f, Q_SWI = 1024.0f;
constexpr float Q_SH = 32.0f, Q_SW1 = 1024.0f, Q_SA = 4.0f, Q_SW2 = 2048.0f, Q_SY = 64.0f;
__device__ __forceinline__ unsigned pk4_fp8(float a, float b, float c, float d) {
    a = fminf(fmaxf(a, -448.f), 448.f); b = fminf(fmaxf(b, -448.f), 448.f); c = fminf(fmaxf(c, -448.f), 448.f); d = fminf(fmaxf(d, -448.f), 448.f);
    int w = 0; w = __builtin_amdgcn_cvt_pk_fp8_f32(a, b, w, false); w = __builtin_amdgcn_cvt_pk_fp8_f32(c, d, w, true); return (unsigned)w; }
__device__ __forceinline__ int fresh_lane() { int l; asm volatile("v_mbcnt_lo_u32_b32 %0, -1, 0\n\tv_mbcnt_hi_u32_b32 %0, -1, %0" : "=v"(l)); return l; }
__device__ __forceinline__ unsigned pk4_fp8_nc(float a, float b, float c, float d) { int w = 0; w = __builtin_amdgcn_cvt_pk_fp8_f32(a, b, w, false); w = __builtin_amdgcn_cvt_pk_fp8_f32(c, d, w, true); return (unsigned)w; }
__device__ __forceinline__ float wave_sum(float v) {
#pragma unroll
    for (int o = 1; o < 64; o <<= 1) v += __shfl_xor(v, o);
    return v;
}

namespace pg8 {
constexpr int BM = 256, BK = 64, HALF = 128, HTB = HALF * BK * 2, STAGE_BYTES = 8 * HTB, NXCD = 8, WGM = 8;
__host__ __device__ __forceinline__ int lds_byte(int r, int c) { const int st = (r >> 4) * 2 + (c >> 5), rr = r & 15, cc = c & 31, ob = rr * 64 + cc * 2; return st * 1024 + (ob ^ (((ob >> 9) & 1) << 5)); }
__host__ __device__ __forceinline__ void stage_rc(int b, int& R, int& C) { const int st = b / 1024, sb = b % 1024, swz = sb ^ (((sb >> 9) & 1) << 5); R = (st >> 1) * 16 + swz / 64; C = (st & 1) * 32 + (swz % 64) / 2; }
__host__ __device__ __forceinline__ int perm32(int rho) { const int n = rho >> 4, i = rho & 15; return 8 * (i >> 2) + 4 * n + (i & 3); }

struct Unit { int pm, pn, e, mask; };

__device__ __forceinline__ int xcd_remap(int L, int nwg) { const int q = nwg / NXCD, r = nwg % NXCD, xcd = L % NXCD, off = L / NXCD; return (xcd < r ? xcd * (q + 1) : r * (q + 1) + (xcd - r) * q) + off; }

struct StaticOrder {
    static constexpr bool HAS_MASK = false;
    const char* A; const char* Bt; int K; int nM, nN, nwg, G, c; int fix_pm, fix_pn;
    __device__ void init(const void* A_, const void* Bt_, int M_, int N_, int K_, int G_, int c_) { A = (const char*)A_; Bt = (const char*)Bt_; K = K_; nM = M_ / BM; nN = N_ / BM; nwg = nM * nN; G = G_; c = c_; fix_pm = -1; fix_pn = 0; }
    __device__ __forceinline__ bool next(int i, Unit& u) const {
        if (fix_pm >= 0) { if (i != 0) return false; u.pm = fix_pm; u.pn = fix_pn; u.e = 0; u.mask = 15; return true; }
        const long L = (long)i * G + c; if (L >= nwg) return false;
        const int wgid = xcd_remap((int)L, nwg);
        const int nig = WGM * nN, gid = wgid / nig, fm = gid * WGM, gsz = (nM - fm) < WGM ? (nM - fm) : WGM;
        u.pm = fm + ((wgid % nig) % gsz); u.pn = (wgid % nig) / gsz; u.e = 0; u.mask = 15;
        if (nN == 16) { const unsigned long long tb = 0xdc543b2a9180fe76ull;        u.pn = (int)((tb >> (4 * u.pn)) & 15ull); }
        return true;
    }
    __device__ __forceinline__ const char* a_base(const Unit& u) const { return A + (size_t)u.pm * BM * K * 2; }
    __device__ __forceinline__ const char* b_base(const Unit& u) const { return Bt + (size_t)u.pn * BM * K * 2; }
};
struct MoeOrder {
    static constexpr bool HAS_MASK = true;
    const char* A; const char* Bt; int K; int NCT; int G, c; const LAS int* ts; bool gather; int maxS;
    __device__ __forceinline__ bool next(int i, Unit& u) const {
        const int nwg = ts[NE] * NCT, full = nwg / G, rem = nwg - full * G;
        int S = 1; if (rem > 0) { if (maxS >= 4 && rem * 4 <= G) S = 4; else if (maxS >= 2 && rem * 2 <= G) S = 2; }
        long L; int sub = 0;
        if (i < full) L = (long)i * G + c;
        else if (i == full && c < rem * S) { sub = c / rem; L = (long)full * G + (c - sub * rem); }
        else return false;
        u.mask = __builtin_amdgcn_readfirstlane((i < full || S == 1) ? 15 : S == 2 ? (sub ? 12 : 3) : (1 << sub));
        const int wgid = xcd_remap((int)L, nwg);
        int e = NE - 1;
        for (int e4 = 0; e4 < NE; e4 += 4) { const int a0 = ts[e4 + 1], a1 = ts[e4 + 2], a2 = ts[e4 + 3], a3 = ts[e4 + 4];
            if (wgid < a3 * NCT) { e = e4 + (wgid < a0 * NCT ? 0 : wgid < a1 * NCT ? 1 : wgid < a2 * NCT ? 2 : 3); break; } }
        const int r = wgid - ts[e] * NCT, R = ts[e + 1] - ts[e];
        u.pm = __builtin_amdgcn_readfirstlane(ts[e] + r % R); u.pn = __builtin_amdgcn_readfirstlane(r / R); u.e = __builtin_amdgcn_readfirstlane(e); return true;
    }
    __device__ __forceinline__ const char* a_base(const Unit& u) const { return gather ? A : A + (size_t)u.pm * BM * K * 2; }
    __device__ __forceinline__ const char* b_base(const Unit& u) const { return Bt + ((size_t)u.e * NCT + u.pn) * BM * K * 2; }
};

__device__ __forceinline__ unsigned cvt_pk_bf16(float lo, float hi) { unsigned r; asm volatile("v_cvt_pk_bf16_f32 %0, %1, %2" : "=v"(r) : "v"(lo), "v"(hi)); return r; }

typedef f32x4 Acc[2][2][4][2];

struct EpiProj {
    static constexpr bool PERM = true, HAS_MID = false;
    bf16_t* O; const float* lb;
    int pn_off; float gscale;
    template <int MODE>
    __device__ __forceinline__ void body(const Acc& acc, const int row0, const int col0) const {
        float lbv[2][8];
        if (MODE == 2) {
#pragma unroll
            for (int bj = 0; bj < 2; ++bj) { const f32x4 l0 = *(const f32x4*)(lb + col0 + bj * HALF - C_FF), l1 = *(const f32x4*)(lb + col0 + bj * HALF - C_FF + 4);
#pragma unroll
                for (int j = 0; j < 4; ++j) { lbv[bj][j] = l0[j]; lbv[bj][4 + j] = l1[j]; } }
        }
#pragma unroll
        for (int ai = 0; ai < 2; ++ai)
#pragma unroll
            for (int m = 0; m < 4; ++m) { bf16_t* rowp = O + (size_t)(row0 + ai * HALF + m * 16) * NIN + col0;
                if (MODE == 3) {
                    float v0[8], v1[8];
#pragma unroll
                    for (int p = 0; p < 4; ++p) { const f32x2 xa = {acc[ai][0][m][p >> 1][2 * (p & 1)], acc[ai][0][m][p >> 1][2 * (p & 1) + 1]}, xb = {acc[ai][1][m][p >> 1][2 * (p & 1)], acc[ai][1][m][p >> 1][2 * (p & 1) + 1]};
                        const float ks = -1.4426950408889634f * gscale; const f32x2 ta = xa * ks, tb = xb * ks;
                        f32x2 ea, eb; ea.x = __builtin_amdgcn_exp2f(ta.x); ea.y = __builtin_amdgcn_exp2f(ta.y); eb.x = __builtin_amdgcn_exp2f(tb.x); eb.y = __builtin_amdgcn_exp2f(tb.y);
                        const f32x2 da = ea + 1.0f, db = eb + 1.0f;
                        f32x2 ra, rb; ra.x = __builtin_amdgcn_rcpf(da.x); ra.y = __builtin_amdgcn_rcpf(da.y); rb.x = __builtin_amdgcn_rcpf(db.x); rb.y = __builtin_amdgcn_rcpf(db.y);
                        const f32x2 rr = db * ra;
                        v0[2 * p] = rr.x; v0[2 * p + 1] = rr.y; v1[2 * p] = rb.x; v1[2 * p + 1] = rb.y; }
                    u32x4 w0, w1; w0.x = cvt_pk_bf16(v0[0], v0[1]); w0.y = cvt_pk_bf16(v0[2], v0[3]); w0.z = cvt_pk_bf16(v0[4], v0[5]); w0.w = cvt_pk_bf16(v0[6], v0[7]);
                    w1.x = cvt_pk_bf16(v1[0], v1[1]); w1.y = cvt_pk_bf16(v1[2], v1[3]); w1.z = cvt_pk_bf16(v1[4], v1[5]); w1.w = cvt_pk_bf16(v1[6], v1[7]);
                    *(u32x4*)(rowp) = w0; *(u32x4*)(rowp + HALF) = w1;
                } else {
#pragma unroll
                for (int bj = 0; bj < 2; ++bj) { float v[8];
#pragma unroll
                    for (int p = 0; p < 4; ++p) { f32x2 x = {acc[ai][bj][m][p >> 1][2 * (p & 1)], acc[ai][bj][m][p >> 1][2 * (p & 1) + 1]};
                        if (MODE != 0) { const f32x2 t = x * (-1.4426950408889634f); f32x2 e; e.x = __builtin_amdgcn_exp2f(t.x); e.y = __builtin_amdgcn_exp2f(t.y);
                            const f32x2 d = e + 1.0f; f32x2 sg; sg.x = __builtin_amdgcn_rcpf(d.x); sg.y = __builtin_amdgcn_rcpf(d.y);
                            if (MODE == 1) x = x * sg;
                            else { const f32x2 l = {lbv[bj][2 * p], lbv[bj][2 * p + 1]}; const f32x2 f = l + (1.0f - l) * sg;
                                f32x2 lg; lg.x = __builtin_amdgcn_logf(f.x); lg.y = __builtin_amdgcn_logf(f.y); x = lg * 0.6931471805599453f; } }
                        v[2 * p] = x.x; v[2 * p + 1] = x.y; }
                    u32x4 w; w.x = cvt_pk_bf16(v[0], v[1]); w.y = cvt_pk_bf16(v[2], v[3]); w.z = cvt_pk_bf16(v[4], v[5]); w.w = cvt_pk_bf16(v[6], v[7]);
                    *(u32x4*)(rowp + bj * HALF) = w; } } }
    }
    __device__ __forceinline__ void operator()(const Acc& acc, const Unit& u, int wr, int wc, int fr, int fq) const {
        const int pn = u.pn + pn_off;
        const int row0 = u.pm * BM + wr * 64 + fr, col0 = pn * BM + wc * 32 + 8 * fq;
        if (pn >= 16) body<3>(acc, row0, col0);
        else if (pn >= 8 && pn < 12) body<2>(acc, row0, col0);
        else if ((pn >= 6 && pn < 8) || (pn >= 14 && pn < 16)) body<1>(acc, row0, col0);
        else body<0>(acc, row0, col0);
    }
};
struct EpiMix {
    static constexpr bool PERM = true, HAS_MID = true;
    const bf16_t* proj; bf16_t* MIX;
    __device__ __forceinline__ void mid(Acc& acc, const Unit& u, int wr, int wc, int fr, int fq) const {
        unsigned base = (unsigned)((u.pm * BM + wr * 64 + fr) * NIN + u.pn * 512 + wc * 32 + 8 * fq) * 2u;
        asm volatile("" : "+v"(base));
        u32x4 g[2][4][2];
#pragma unroll
        for (int ai = 0; ai < 2; ++ai)
#pragma unroll
            for (int m = 0; m < 4; ++m)
#pragma unroll
                for (int bj = 0; bj < 2; ++bj) { const unsigned off = base + (unsigned)(((ai * HALF + m * 16) * NIN + bj * 256) * 2); g[ai][m][bj] = *(const u32x4*)((const char*)proj + C_GA * 2 + off); }
#pragma unroll
        for (int ai = 0; ai < 2; ++ai)
#pragma unroll
            for (int m = 0; m < 4; ++m)
#pragma unroll
                for (int bj = 0; bj < 2; ++bj)
#pragma unroll
                    for (int q = 0; q < 4; ++q) { acc[ai][bj][m][q >> 1][2 * (q & 1)] *= bflo(g[ai][m][bj][q]); acc[ai][bj][m][q >> 1][2 * (q & 1) + 1] *= bfhi(g[ai][m][bj][q]); }
    }
    __device__ __forceinline__ void operator()(const Acc& acc, const Unit& u, int wr, int wc, int fr, int fq) const {
        const int row0 = u.pm * BM + wr * 64 + fr, col0 = u.pn * BM + wc * 32 + 8 * fq;
        unsigned base = (unsigned)(row0 * NIN + u.pn * 512 + wc * 32 + 8 * fq) * 2u;
        asm volatile("" : "+v"(base));
        u32x4 g[2][4][2];
#pragma unroll
        for (int ai = 0; ai < 2; ++ai)
#pragma unroll
            for (int m = 0; m < 4; ++m)
#pragma unroll
                for (int bj = 0; bj < 2; ++bj) { const unsigned off = base + (unsigned)(((ai * HALF + m * 16) * NIN + bj * 256) * 2); g[ai][m][bj] = *(const u32x4*)((const char*)proj + (C_GA + 128) * 2 + off); }
#pragma unroll
        for (int ai = 0; ai < 2; ++ai)
#pragma unroll
            for (int m = 0; m < 4; ++m) { const size_t row = (size_t)(row0 + ai * HALF + m * 16);
#pragma unroll
                for (int bj = 0; bj < 2; ++bj) { const int col = col0 + bj * HALF; const u32x4 gg = g[ai][m][bj];
                    const f32x4 a0 = acc[ai][bj][m][0], a1 = acc[ai][bj][m][1];
                    u32x4 w;
                    w.x = cvt_pk_bf16(bflo(gg.x) * a0[0], bfhi(gg.x) * a0[1]); w.y = cvt_pk_bf16(bflo(gg.y) * a0[2], bfhi(gg.y) * a0[3]);
                    w.z = cvt_pk_bf16(bflo(gg.z) * a1[0], bfhi(gg.z) * a1[1]); w.w = cvt_pk_bf16(bflo(gg.w) * a1[2], bfhi(gg.w) * a1[3]);
                    *(u32x4*)(MIX + row * D + col) = w; } }
    }
};
struct EpiResid {
    static constexpr bool PERM = true, HAS_MID = false;
    bf16_t* OUTB;
    __device__ __forceinline__ void operator()(const Acc& acc, const Unit& u, int wr, int wc, int fr, int fq) const {
        const int row0 = u.pm * BM + wr * 64 + fr, col0 = u.pn * BM + wc * 32 + 8 * fq;
#pragma unroll
        for (int ai = 0; ai < 2; ++ai)
#pragma unroll
            for (int m = 0; m < 4; ++m) { const size_t row = (size_t)(row0 + ai * HALF + m * 16);
#pragma unroll
                for (int bj = 0; bj < 2; ++bj) { const f32x4 a0 = acc[ai][bj][m][0], a1 = acc[ai][bj][m][1];
                    u32x4 w; w.x = cvt_pk_bf16(a0[0], a0[1]); w.y = cvt_pk_bf16(a0[2], a0[3]); w.z = cvt_pk_bf16(a1[0], a1[1]); w.w = cvt_pk_bf16(a1[2], a1[3]);
                    *(u32x4*)(OUTB + row * D + col0 + bj * HALF) = w; } }
    }
};
struct EpiSwiglu {
    static constexpr bool PERM = true, HAS_MID = false;
    unsigned char* ACT; const float* b1;
    __device__ __forceinline__ void operator()(const Acc& acc, const Unit& u, int wr, int wc, int fr, int fq) const {
        const int row0 = u.pm * BM + wr * 64 + fr, colc = u.pn * HALF + wc * 32 + 8 * fq;
        const float* bp = b1 + (size_t)u.e * (2 * DFF) + colc;
        const f32x4 bg0 = *(const f32x4*)(bp), bg1 = *(const f32x4*)(bp + 4), bl0 = *(const f32x4*)(bp + DFF), bl1 = *(const f32x4*)(bp + DFF + 4);
        __builtin_amdgcn_s_waitcnt(0x0F70);
#pragma unroll
        for (int ai = 0; ai < 2; ++ai) { if (!((u.mask >> (2 * ai)) & 3)) continue;
#pragma unroll
            for (int m = 0; m < 4; ++m) { const size_t row = (size_t)(row0 + ai * HALF + m * 16);
                float a[8];
#pragma unroll
                for (int n = 0; n < 2; ++n) { const f32x4 gb4 = n ? bg1 : bg0, lb4 = n ? bl1 : bl0;
#pragma unroll
                    for (int h2 = 0; h2 < 2; ++h2) {
                        f32x2 g = (f32x2){acc[ai][0][m][n][2 * h2], acc[ai][0][m][n][2 * h2 + 1]} * (1.0f / (Q_SH * Q_SW1)) + (f32x2){gb4[2 * h2], gb4[2 * h2 + 1]};
                        f32x2 l = (f32x2){acc[ai][1][m][n][2 * h2], acc[ai][1][m][n][2 * h2 + 1]} * (1.0f / (Q_SH * Q_SW1)) + (f32x2){lb4[2 * h2], lb4[2 * h2 + 1]};
                        g.x = fminf(g.x, SW_LIMIT); g.y = fminf(g.y, SW_LIMIT);
                        l.x = __builtin_amdgcn_fmed3f(l.x, -SW_LIMIT, SW_LIMIT); l.y = __builtin_amdgcn_fmed3f(l.y, -SW_LIMIT, SW_LIMIT);
                        const f32x2 t = g * (-SW_ALPHA * 1.4426950408889634f);
                        f32x2 e; e.x = __builtin_amdgcn_exp2f(t.x); e.y = __builtin_amdgcn_exp2f(t.y);
                        const f32x2 d = e + 1.0f;
                        f32x2 r; r.x = __builtin_amdgcn_rcpf(d.x); r.y = __builtin_amdgcn_rcpf(d.y);
                        const f32x2 o = (g * r) * (l * Q_SA + Q_SA);
                        a[4 * n + 2 * h2] = o.x; a[4 * n + 2 * h2 + 1] = o.y; } }
                u32x2 w; w.x = pk4_fp8_nc(a[0], a[1], a[2], a[3]); w.y = pk4_fp8_nc(a[4], a[5], a[6], a[7]);
                *(u32x2*)(ACT + row * DFF + colc) = w; } }
    }
};
struct EpiMoeOut {
    static constexpr bool PERM = true, HAS_MID = false;
    unsigned char* Y; const float* b2; const float* slot_gate;
    __device__ __forceinline__ void operator()(const Acc& acc, const Unit& u, int wr, int wc, int fr, int fq) const {
        const int row0 = u.pm * BM + wr * 64 + fr, col0 = u.pn * BM + wc * 32 + 8 * fq;
        f32x4 bv[2][2];
#pragma unroll
        for (int bj = 0; bj < 2; ++bj)
#pragma unroll
            for (int n = 0; n < 2; ++n) bv[bj][n] = *(const f32x4*)(b2 + (size_t)u.e * D + col0 + bj * HALF + 4 * n);
        float gtv[2][4];
#pragma unroll
        for (int ai = 0; ai < 2; ++ai)
#pragma unroll
            for (int m = 0; m < 4; ++m) gtv[ai][m] = slot_gate[(size_t)(row0 + ai * HALF + m * 16)];
        __builtin_amdgcn_s_waitcnt(0x0F70);
#pragma unroll
        for (int ai = 0; ai < 2; ++ai) { if (!((u.mask >> (2 * ai)) & 3)) continue;
#pragma unroll
            for (int m = 0; m < 4; ++m) { const size_t row = (size_t)(row0 + ai * HALF + m * 16); const float gt = gtv[ai][m];
#pragma unroll
                for (int bj = 0; bj < 2; ++bj) { if (!((u.mask >> (2 * ai + bj)) & 1)) continue; const float gs = gt * Q_SY; const f32x4 v0 = (acc[ai][bj][m][0] * (1.0f / (Q_SA * Q_SW2)) + bv[bj][0]) * gs, v1 = (acc[ai][bj][m][1] * (1.0f / (Q_SA * Q_SW2)) + bv[bj][1]) * gs;
                    u32x2 w; w.x = pk4_fp8(v0[0], v0[1], v0[2], v0[3]); w.y = pk4_fp8(v1[0], v1[1], v1[2], v1[3]);
                    *(u32x2*)(Y + row * D + col0 + bj * HALF) = w; } } }
    }
};

typedef int i32x4 __attribute__((ext_vector_type(4)));
typedef int i32x8 __attribute__((ext_vector_type(8)));
template <bool GATHER, bool ALIGN_EPI, bool FP8, class Epi, class Sched>
__device__ __forceinline__ void gemm_phase(LAS unsigned char* lds, LAS unsigned* tokbuf, const int* tokidx, const int K, const Sched& S, const Epi& E, const int wid  ) {
    const int lane = fresh_lane(), tid = wid * 64 + lane, wr = wid >> 2, wc = wid & 3, fr = lane & 15, fq = lane >> 4;
    const int nt = K / BK;
    unsigned voffB[2], oA[2][2], cA2[2]; int RA[2];
    const unsigned hstep = (unsigned)HALF * (unsigned)K * 2u;
#pragma unroll
    for (int i = 0; i < 2; ++i) { int R, C; stage_rc(tid * 16 + i * 8192, R, C); const int Rb = Epi::PERM ? ((R & ~31) + perm32(R & 31)) : R;
        RA[i] = R; cA2[i] = (unsigned)C * 2u; voffB[i] = (unsigned)(Rb * K + C) * 2u;
        if constexpr (!GATHER) { oA[0][i] = (unsigned)(R * K + C) * 2u; oA[1][i] = oA[0][i] + hstep; } }
    const size_t kstep = (size_t)(BK * 2);
    const unsigned ldsw = (unsigned)wid * 1024u;
    const int aoff = lds_byte(wr * 64 + fr, fq * 8), boff = lds_byte(wc * 32 + fr, fq * 8);
#define PG8_SA(b, h) (((b) * 2 + (h)) * HTB)
#define PG8_SB(b, h) ((4 + (b) * 2 + (h)) * HTB)
#define PG8_STAGE(bufoff, gbase, voff) do { _Pragma("unroll") for (int _i = 0; _i < 2; ++_i) { unsigned vo_ = (voff)[_i]; asm volatile("" : "+v"(vo_));   \
        __builtin_amdgcn_global_load_lds((const unsigned*)((const char*)(gbase) + vo_), (LAS unsigned*)(lds + (bufoff) + ldsw + _i * 8192), 16, 0, 0); } } while (0)
#define PG8_LDA(dst, b, h) do { _Pragma("unroll") for (int m = 0; m < 4; ++m) { if constexpr (FP8) { \
            const i32x4 lo_ = *(const LAS i32x4*)(lds + PG8_SA(b, h) + aoff + m * 2048), hi_ = *(const LAS i32x4*)(lds + PG8_SA(b, h) + aoff + m * 2048 + 1024); \
            dst##8[m] = __builtin_shufflevector(lo_, hi_, 0, 1, 2, 3, 4, 5, 6, 7); } \
        else { _Pragma("unroll") for (int k = 0; k < 2; ++k) dst[m][k] = *(const LAS bf16x8*)(lds + PG8_SA(b, h) + aoff + m * 2048 + k * 1024); } } } while (0)
#define PG8_LDB(dst, b, h) do { _Pragma("unroll") for (int n = 0; n < 2; ++n) { if constexpr (FP8) { \
            const i32x4 lo_ = *(const LAS i32x4*)(lds + PG8_SB(b, h) + boff + n * 2048), hi_ = *(const LAS i32x4*)(lds + PG8_SB(b, h) + boff + n * 2048 + 1024); \
            dst##8[n] = __builtin_shufflevector(lo_, hi_, 0, 1, 2, 3, 4, 5, 6, 7); } \
        else { _Pragma("unroll") for (int k = 0; k < 2; ++k) dst[n][k] = *(const LAS bf16x8*)(lds + PG8_SB(b, h) + boff + n * 2048 + k * 1024); } } } while (0)
#define PG8_MMA(ai, bj, At, Bt) do { if (Sched::HAS_MASK && !((cur.mask >> (2 * (ai) + (bj))) & 1)) break; __builtin_amdgcn_s_setprio(1); _Pragma("unroll") for (int m = 0; m < 4; ++m) _Pragma("unroll") for (int n = 0; n < 2; ++n) { \
        if constexpr (FP8) acc[ai][bj][m][n] = __builtin_amdgcn_mfma_scale_f32_16x16x128_f8f6f4(Bt##8[n], At##8[m], acc[ai][bj][m][n], 0, 0, 0, 0x7F7F7F7F, 0, 0x7F7F7F7F); \
        else { _Pragma("unroll") for (int k = 0; k < 2; ++k) acc[ai][bj][m][n] = __builtin_amdgcn_mfma_f32_16x16x32_bf16(Bt[n][k], At[m][k], acc[ai][bj][m][n], 0, 0, 0); } } \
        __builtin_amdgcn_s_setprio(0); } while (0)
#define PG8_WAIT_V(n) asm volatile("s_waitcnt vmcnt(" #n ")" ::: "memory")
#define PG8_WAIT_L(n) asm volatile("s_waitcnt lgkmcnt(" #n ")" ::: "memory")
#define PG8_BAR __builtin_amdgcn_s_barrier()
#define PG8_SCHED __builtin_amdgcn_sched_barrier(0)
    Unit cur, nxt; int ui = 0;
    if (!S.next(0, cur)) return;
    Acc acc;
#pragma unroll
    for (int a = 0; a < 2; ++a)
#pragma unroll
        for (int b = 0; b < 2; ++b)
#pragma unroll
            for (int m = 0; m < 4; ++m)
#pragma unroll
                for (int n = 0; n < 2; ++n) acc[a][b][m][n] = (f32x4){0.f, 0.f, 0.f, 0.f};
    bf16x8 At[4][2], B0[2][2], B1[2][2]; i32x8 At8[4], B08[2], B18[2];
    const char* cA = S.a_base(cur); const char* cB = S.b_base(cur);
    if constexpr (GATHER) {
#pragma unroll
        for (int h = 0; h < 2; ++h)
#pragma unroll
            for (int i = 0; i < 2; ++i) oA[h][i] = (unsigned)tokidx[cur.pm * BM + h * HALF + RA[i]] * (unsigned)(K * 2) + cA2[i];
    }
    PG8_STAGE(PG8_SB(0, 0), cB, voffB); PG8_STAGE(PG8_SB(0, 1), cB + hstep, voffB); PG8_STAGE(PG8_SA(0, 0), cA, oA[0]); PG8_STAGE(PG8_SA(0, 1), cA, oA[1]);
    if (wr == 1) PG8_BAR;
    PG8_WAIT_V(2); PG8_BAR;
    PG8_STAGE(PG8_SB(1, 0), cB + kstep, voffB); PG8_STAGE(PG8_SA(1, 0), cA + kstep, oA[0]); PG8_STAGE(PG8_SB(1, 1), cB + hstep + kstep, voffB);
    PG8_WAIT_V(6); PG8_BAR;
    for (;;) {
        const bool has_next = S.next(ui + 1, nxt);
        const char* nA = has_next ? S.a_base(nxt) : cA; const char* nB = has_next ? S.b_base(nxt) : cB;
        if constexpr (GATHER) {
            if (has_next && wid < 4)
                __builtin_amdgcn_global_load_lds((const unsigned*)(tokidx + nxt.pm * BM + tid), (LAS unsigned*)(tokbuf + ((ui + 1) & 1) * 256 + wid * 64), 4, 0, 0);
        }
#pragma nounroll
        for (int t = 0; t < nt; t += 2) {
            const bool last = (t == nt - 2);
            if constexpr (Epi::HAS_MID) { if (t == nt / 2) E.mid(acc, cur, wr, wc, fr, fq); }
            const char* a1 = cA + (size_t)(t + 1) * kstep;
            const char* a2 = last ? nA : cA + (size_t)(t + 2) * kstep; const char* b2 = last ? nB : cB + (size_t)(t + 2) * kstep;
            const char* a3 = a2 + kstep; const char* b3 = b2 + kstep;
            PG8_LDB(B0, 0, 0); PG8_LDB(B1, 0, 1); PG8_SCHED; PG8_LDA(At, 0, 0); PG8_STAGE(PG8_SA(1, 1), a1, oA[1]);
            PG8_WAIT_V(8); PG8_WAIT_L(0); PG8_BAR; PG8_MMA(0, 0, At, B0); PG8_MMA(0, 1, At, B1); PG8_BAR; PG8_SCHED;
            if constexpr (GATHER) {
                if (last && has_next) {
#pragma unroll
                    for (int h = 0; h < 2; ++h)
#pragma unroll
                        for (int i = 0; i < 2; ++i) oA[h][i] = tokbuf[((ui + 1) & 1) * 256 + h * HALF + RA[i]] * (unsigned)(K * 2) + cA2[i];
                }
            }
            PG8_LDA(At, 0, 1); PG8_STAGE(PG8_SB(0, 0), b2, voffB); PG8_STAGE(PG8_SB(0, 1), b2 + hstep, voffB); PG8_STAGE(PG8_SA(0, 0), a2, oA[0]);
            PG8_WAIT_V(8); PG8_WAIT_L(0); PG8_BAR; PG8_MMA(1, 0, At, B0); PG8_MMA(1, 1, At, B1); PG8_BAR; PG8_SCHED;
            PG8_LDB(B0, 1, 0); PG8_LDB(B1, 1, 1); PG8_SCHED; PG8_LDA(At, 1, 0); PG8_STAGE(PG8_SA(0, 1), a2, oA[1]);
            PG8_WAIT_V(8); PG8_WAIT_L(0); PG8_BAR; PG8_MMA(0, 0, At, B0); PG8_MMA(0, 1, At, B1); PG8_BAR; PG8_SCHED;
            PG8_LDA(At, 1, 1); PG8_STAGE(PG8_SB(1, 0), b3, voffB); PG8_STAGE(PG8_SB(1, 1), b3 + hstep, voffB); PG8_STAGE(PG8_SA(1, 0), a3, oA[0]);
            PG8_WAIT_V(8); PG8_WAIT_L(0); PG8_BAR; PG8_MMA(1, 0, At, B0); PG8_MMA(1, 1, At, B1); PG8_BAR; PG8_SCHED;
        }
        if constexpr (ALIGN_EPI) { if (wr == 0) PG8_BAR; }
        E(acc, cur, wr, wc, fr, fq);
        __builtin_amdgcn_s_waitcnt(0x0F70);
        if (!has_next) break;
#pragma unroll
        for (int a = 0; a < 2; ++a)
#pragma unroll
            for (int b = 0; b < 2; ++b)
#pragma unroll
                for (int m = 0; m < 4; ++m)
#pragma unroll
                    for (int n = 0; n < 2; ++n) acc[a][b][m][n] = (f32x4){0.f, 0.f, 0.f, 0.f};
        cur = nxt; cA = nA; cB = nB; ++ui;
        if constexpr (ALIGN_EPI) { if (wr == 1) PG8_BAR; }
    }
    PG8_WAIT_V(0);
    if constexpr (!ALIGN_EPI) { if (wr == 0) PG8_BAR; }
    PG8_BAR;
#undef PG8_SA
#undef PG8_SB
#undef PG8_STAGE
#undef PG8_LDA
#undef PG8_LDB
#undef PG8_MMA
#undef PG8_WAIT_V
#undef PG8_WAIT_L
#undef PG8_BAR
#undef PG8_SCHED
}
}

#define XB_TMO      128
#define XB_XCNT(j)  (256  + 64 * (j))
#define XB_XSUB(j)  (1280 + 64 * (j))
#define XB_XGEN(j)  (2304 + 64 * (j))
#define XB_TOP      3328
#define XB_TOPGEN   3392
#define XCD_BAR_WORDS 3456
#define XB_SPIN_CAP (1u << 18)
__device__ __forceinline__ unsigned xb_ld(unsigned* p)              { return __hip_atomic_load(p, __ATOMIC_RELAXED, __HIP_MEMORY_SCOPE_AGENT); }
__device__ __forceinline__ unsigned xb_add(unsigned* p, unsigned v) { return __hip_atomic_fetch_add(p, v, __ATOMIC_RELAXED, __HIP_MEMORY_SCOPE_AGENT); }
__device__ __forceinline__ unsigned xb_xcc_id() { return (unsigned)__builtin_amdgcn_s_getreg((3 << 11) | 20) & 0xFu; }
#define XB_SPIN(cond, bar) do { unsigned _sp = 0; while (cond) { __builtin_amdgcn_s_sleep(1); \
    if ((++_sp & 255u) == 0u) { if (xb_ld(&(bar)[XB_TMO])) break; if (_sp > XB_SPIN_CAP) { atomicAdd(&(bar)[XB_TMO], 1u); break; } } } } while (0)
struct XcdBarrier { unsigned* bar; unsigned x; volatile LAS unsigned* st; };
__device__ __forceinline__ XcdBarrier xcd_barrier_post(unsigned* bar, volatile LAS unsigned* st, bool thread0) {
    XcdBarrier b; b.bar = bar; b.x = xb_xcc_id(); b.st = st;
    if (thread0) (void)xb_add(&bar[XB_XCNT(b.x)], 1u);
    return b;
}
__device__ __forceinline__ void xcd_barrier_complete(unsigned* bar, unsigned x, unsigned& nloc, unsigned& nx) {
    const unsigned G = gridDim.x * gridDim.y * gridDim.z;
    unsigned sum, cnt, mine, sp = 0u;
    for (;;) {
        sum = 0u; cnt = 0u; mine = 0u;
#pragma unroll
        for (unsigned j = 0; j < 16; ++j) { const unsigned c = xb_ld(&bar[XB_XCNT(j)]); sum += c; cnt += (c > 0u) ? 1u : 0u; mine = (j == x) ? c : mine; }
        if (sum == G) break;
        __builtin_amdgcn_s_sleep(1);
        if ((++sp & 255u) == 0u) { if (xb_ld(&bar[XB_TMO])) break; if (sp > XB_SPIN_CAP) { atomicAdd(&bar[XB_TMO], 1u); break; } }
    }
    nloc = mine > 0u ? mine : 1u; nx = cnt > 0u ? cnt : 1u;
}
__device__ __forceinline__ void xcd_barrier(const XcdBarrier& b, bool thread0  ) {
    asm volatile("s_waitcnt vmcnt(0)" ::: "memory");
    __syncthreads();
    if (thread0) {
        unsigned* bar = b.bar;
        __builtin_amdgcn_s_waitcnt(0);
        unsigned nloc = b.st[0], nx = b.st[1];
        if (nloc == 0u) { xcd_barrier_complete(bar, b.x, nloc, nx); b.st[0] = nloc; b.st[1] = nx; }
        const unsigned old = xb_add(&bar[XB_XSUB(b.x)], 1u);
        const unsigned gen = old / nloc;
        if (old + 1u == (gen + 1u) * nloc) {
            __builtin_amdgcn_fence(__ATOMIC_RELEASE, "agent");
            asm volatile("s_waitcnt vmcnt(0)" ::: "memory");
            const unsigned og = xb_add(&bar[XB_TOP], 1u);
            const unsigned tg = og / nx;
            if (og + 1u == (tg + 1u) * nx) xb_add(&bar[XB_TOPGEN], 1u);
            else XB_SPIN(xb_ld(&bar[XB_TOPGEN]) == tg, bar);
            __builtin_amdgcn_fence(__ATOMIC_ACQUIRE, "agent");
            xb_add(&bar[XB_XGEN(b.x)], 1u);
            asm volatile("s_waitcnt vmcnt(0)" ::: "memory");
        } else {
            XB_SPIN(xb_ld(&bar[XB_XGEN(b.x)]) == gen, bar);
            __builtin_amdgcn_fence(__ATOMIC_ACQUIRE, "agent");
            asm volatile("s_waitcnt vmcnt(0)" ::: "memory");
        }
    }
    __syncthreads();
}

__device__ __forceinline__ void grp_barrier(unsigned* ctl, int seam, int g, bool thread0, unsigned* bar, volatile LAS unsigned* memo) {
    asm volatile("s_waitcnt vmcnt(0)" ::: "memory");
    __syncthreads();
    if (thread0) {
        unsigned sm = memo[0];
        if (sm == 0u) { unsigned* gx = ctl + CW_GX + g * 32;
            const unsigned x0 = xb_ld(gx), x1 = xb_ld(gx + 1), x2 = xb_ld(gx + 2), x3 = xb_ld(gx + 3);
            sm = ((x0 != 0u) && (x0 == x1) && (x1 == x2) && (x2 == x3)) ? 1u : 2u; memo[0] = sm; }
        const bool same = (sm == 1u);
        if (!same) { __builtin_amdgcn_fence(__ATOMIC_RELEASE, "agent"); asm volatile("s_waitcnt vmcnt(0)" ::: "memory"); }
        unsigned* cnt = ctl + CW_GRP + (seam * 64 + g) * 32;
        const unsigned old = xb_add(cnt, 1u);
        if (old != 3u) XB_SPIN(xb_ld(cnt) < 4u, bar);
        if (!same) { __builtin_amdgcn_fence(__ATOMIC_ACQUIRE, "agent"); asm volatile("s_waitcnt vmcnt(0)" ::: "memory"); }
    }
    __syncthreads();
}

struct Frame {
    LAS unsigned char* lds;
    volatile LAS unsigned* MISC;
    gu32* ctl;
    int tid, lane, wave;
    int vcu, G;
    int rb0, rbstep;
    const float *x, *w_in, *conv_w, *p_a, *lb_logits, *norm_w, *p_b, *w_o, *ln1_g, *ln1_b, *w_router, *b_router, *w1, *b1, *w2, *b2, *ln2_g, *ln2_b;
    float* out;
    unsigned char* ws;
};
#define WSP(T, off) ((T*)(F.ws + (off)))

__device__ __forceinline__ void p0_transpose_item(const float* W, int K, int N, bf16_t* WT, int k0, int n0, int dst_row0, LAS float* scr, int lane, int ldk = 0, int kdst0 = 0) {
    if (ldk == 0) ldk = K;
    { float r[32]; const float* p = W + (size_t)(k0 + (lane >> 5)) * N + n0 + (lane & 31);
#pragma unroll
      for (int i = 0; i < 32; ++i) r[i] = __builtin_nontemporal_load(p + (size_t)(2 * i) * N);
      asm volatile("s_waitcnt vmcnt(0)" ::: "memory");
#pragma unroll
      for (int i = 0; i < 32; ++i) scr[(2 * i + (lane >> 5)) * 33 + (lane & 31)] = r[i]; }
    asm volatile("s_waitcnt lgkmcnt(0)" ::: "memory");
    const int c = lane & 7;
#pragma unroll
    for (int j = 0; j < 4; ++j) { const int n = (lane >> 3) + 8 * j; const LAS float* s = scr + (8 * c) * 33 + n;
        u32x4 o; o.x = pk2(s[0 * 33], s[1 * 33]); o.y = pk2(s[2 * 33], s[3 * 33]); o.z = pk2(s[4 * 33], s[5 * 33]); o.w = pk2(s[6 * 33], s[7 * 33]);
        *(u32x4*)(WT + (size_t)(dst_row0 + n) * ldk + kdst0 + k0 + 8 * c) = o; }
    asm volatile("s_waitcnt lgkmcnt(0)" ::: "memory");
}
__device__ __forceinline__ void p0_transpose_item_fp8(const float* W, int K, int N, unsigned char* WT, int k0, int n0, int dst_row0, float scale, LAS float* scrf, int lane) {
    LAS unsigned char* scr = (LAS unsigned char*)scrf;
    float r[64];
    { const float* p = W + (size_t)(k0 + (lane >> 5)) * N + n0 + (lane & 31);
#pragma unroll
      for (int i = 0; i < 64; ++i) r[i] = __builtin_nontemporal_load(p + (size_t)(2 * i) * N); }
#pragma unroll
    for (int q = 0; q < 32; ++q) {
        const float a = r[2 * q], b = r[2 * q + 1];
        const float ao = __shfl_xor(a, 32), bo = __shfl_xor(b, 32);
        if ((q & 1) == (lane >> 5)) { const float v0 = (lane >> 5) ? ao : a, v1 = (lane >> 5) ? a : ao, v2 = (lane >> 5) ? bo : b, v3 = (lane >> 5) ? b : bo;
            *(LAS unsigned*)(scr + (lane & 31) * 144 + 4 * q) = pk4_fp8(v0 * scale, v1 * scale, v2 * scale, v3 * scale); }
    }
    asm volatile("s_waitcnt lgkmcnt(0)" ::: "memory");
    const int c = lane & 7;
#pragma unroll
    for (int j = 0; j < 4; ++j) { const int n = (lane >> 3) + 8 * j;
        const u32x4 o = *(const LAS u32x4*)(scr + n * 144 + 16 * c);
        *(u32x4*)(WT + (size_t)(dst_row0 + n) * K + k0 + 16 * c) = o; }
    asm volatile("s_waitcnt lgkmcnt(0)" ::: "memory");
}
template <int PART>
__device__ __forceinline__ void p0_prologue(Frame& F) {
    LAS float* scr = (LAS float*)(F.lds + F.wave * 16384);
    const int gw = F.vcu * NWAVES + F.wave, NGW = F.G * NWAVES;
    if (PART == 0) { bf16_t* XB = WSP(bf16_t, WS_XB);
    for (int m0 = F.vcu * NWAVES + F.wave; m0 < M; m0 += 8 * F.G * NWAVES) {
        f32x4 xv[8][4];
#pragma unroll
        for (int q = 0; q < 8; ++q) { const int m = m0 + q * F.G * NWAVES; if (m < M) { const f32x4* xr = (const f32x4*)(F.x + (size_t)m * D) + F.lane;
#pragma unroll
            for (int j = 0; j < 4; ++j) xv[q][j] = __builtin_nontemporal_load(xr + 64 * j); } }
#pragma unroll
        for (int q = 0; q < 8; ++q) { const int m = m0 + q * F.G * NWAVES; if (m < M) { unsigned long long* o8 = (unsigned long long*)(XB + (size_t)m * D) + F.lane;
#pragma unroll
            for (int j = 0; j < 4; ++j) o8[64 * j] = (unsigned long long)pk2(xv[q][j][0], xv[q][j][1]) | ((unsigned long long)pk2(xv[q][j][2], xv[q][j][3]) << 32);
            unsigned* q4 = (unsigned*)(WSP(unsigned char, WS_XQ) + (size_t)m * D) + F.lane;
#pragma unroll
            for (int j = 0; j < 4; ++j) q4[64 * j] = pk4_fp8(xv[q][j][0] * Q_SX, xv[q][j][1] * Q_SX, xv[q][j][2] * Q_SX, xv[q][j][3] * Q_SX); } }
    } }
    constexpr int I_WIN = (D / 64) * (C_GA / 32), I_WINQ = (D / 128) * ((NIN - C_GA) / 32), I_PA = (CD / 64) * (D / 32), I_PB = I_PA, I_WO = (D / 64) * (D / 32);
    constexpr int I_W1E = (D / 128) * (2 * DFF / 32), I_W1 = NE * I_W1E, I_W2E = (DFF / 128) * (D / 32), I_W2 = NE * I_W2E;
    constexpr int NITEMS = I_WIN + I_WINQ + I_PA + I_PB + I_WO + I_W1 + I_W2;
    constexpr int IT_LO = PART == 0 ? 0 : I_WIN + I_WINQ + I_PA + I_PB + I_WO, IT_HI = PART == 0 ? I_WIN + I_WINQ + I_PA + I_PB + I_WO : NITEMS;
    for (int it = IT_LO + gw; it < IT_HI; it += NGW) {
        int r = it;
        if (r < I_WIN) { const int nblk = C_GA / 32, kb = r / nblk, nb = r % nblk; const int n0 = 32 * nb;
            p0_transpose_item(F.w_in, D, NIN, WSP(bf16_t, WS_WIN), 64 * kb, n0, n0, scr, F.lane); continue; } r -= I_WIN;
        if (r < I_WINQ) { const int nblk = (NIN - C_GA) / 32, kb = r / nblk, nb = r % nblk; const int n0 = C_GA + 32 * nb;
            const int isb = n0 >= C_GB ? 1 : 0, jj = n0 - (isb ? C_GB : C_GA), dst = 256 * (jj / 128) + 128 * isb + (jj % 128);
            p0_transpose_item_fp8(F.w_in, D, NIN, WSP(unsigned char, WS_WINQ), 128 * kb, n0, dst, Q_SWI, scr, F.lane); continue; } r -= I_WINQ;
        if (r < I_PA) { const int nblk = D / 32, kb = r / nblk, nb = r % nblk; p0_transpose_item(F.p_a, CD, D, WSP(bf16_t, WS_PAB), 64 * kb, 32 * nb, 32 * nb, scr, F.lane, D, 0); continue; } r -= I_PA;
        if (r < I_PB) { const int nblk = D / 32, kb = r / nblk, nb = r % nblk; p0_transpose_item(F.p_b, CD, D, WSP(bf16_t, WS_PAB), 64 * kb, 32 * nb, 32 * nb, scr, F.lane, D, CD); continue; } r -= I_PB;
        if (r < I_WO) { const int nblk = D / 32, kb = r / nblk, nb = r % nblk; p0_transpose_item(F.w_o, D, D, WSP(bf16_t, WS_WO), 64 * kb, 32 * nb, 32 * nb, scr, F.lane); continue; } r -= I_WO;
        if (r < I_W1) { const int e = r / I_W1E, rr = r % I_W1E; const int nblk = 2 * DFF / 32, kb = rr / nblk, nb = rr % nblk; const int n0 = 32 * nb;
            const int bj = n0 >= DFF ? 1 : 0, cc = n0 - bj * DFF, dst = 256 * (cc / 128) + 128 * bj + (cc % 128);
            p0_transpose_item_fp8(F.w1 + (size_t)e * D * 2 * DFF, D, 2 * DFF, WSP(unsigned char, WS_W1) + (size_t)e * 2 * DFF * D, 128 * kb, n0, dst, Q_SW1, scr, F.lane); continue; } r -= I_W1;
        { const int e = r / I_W2E, rr = r % I_W2E; const int nblk = D / 32, kb = rr / nblk, nb = rr % nblk;
            p0_transpose_item_fp8(F.w2 + (size_t)e * DFF * D, DFF, D, WSP(unsigned char, WS_W2) + (size_t)e * D * DFF, 128 * kb, 32 * nb, 32 * nb, Q_SW2, scr, F.lane); }
    }
    if (PART != 0) return;
    if (blockIdx.x == 0) { float* LB = WSP(float, WS_LB);
        for (int i = F.tid; i < 2 * 512; i += NWAVES * 64) { const int dir = i >> 9, c = i & 511; const float l0 = F.lb_logits[(dir * 2 + 0) * 512 + c], l1 = F.lb_logits[(dir * 2 + 1) * 512 + c];
            LB[i] = 1.0f / (1.0f + expf(l1 - l0)); } }
}

typedef float f32x16 __attribute__((ext_vector_type(16)));
constexpr int HG_QT = 0, HG_KT = 8704, HG_KTT = 17408, HG_VT = 27648, HG_SA = 37888, HG_SB = 38400, HG_DS = 38912, HG_HALFB = 40960;
constexpr int HG_RAW = 2 * HG_HALFB, HG_RAWB = 24576;
static_assert(HG_RAW + 2 * HG_RAWB <= RING_BYTES, "HGRN LDS map");
static_assert(NB * NH * NSC * 64 == M, "pass A units carry 64 conv tokens each");
constexpr int HG_RP = 272, HG_TP = 80;
__device__ __forceinline__ unsigned cvtpk_c(float lo, float hi) { typedef float f2_t __attribute__((ext_vector_type(2))); typedef __bf16 b2_t __attribute__((ext_vector_type(2)));
    f2_t v = {lo, hi}; b2_t b = __builtin_convertvector(v, b2_t); return __builtin_bit_cast(unsigned, b); }
__device__ __forceinline__ int crow(int r, int hh) { return (r & 3) + 8 * (r >> 2) + 4 * hh; }
#define MFMA32(a, b, c) __builtin_amdgcn_mfma_f32_32x32x16_bf16((a), (b), (c), 0, 0, 0)
#define PACK8(x, s) __builtin_bit_cast(bf16x8, (u32x4){cvtpk_c((x)[8 * (s) + 0], (x)[8 * (s) + 1]), cvtpk_c((x)[8 * (s) + 2], (x)[8 * (s) + 3]), cvtpk_c((x)[8 * (s) + 4], (x)[8 * (s) + 5]), cvtpk_c((x)[8 * (s) + 6], (x)[8 * (s) + 7])})
#define HG_LDS_BARRIER() do { asm volatile("s_waitcnt lgkmcnt(0)" ::: "memory"); __builtin_amdgcn_s_barrier(); asm volatile("" ::: "memory"); } while (0)
template <bool PASS_C>
__device__ __forceinline__ void hgrn_mfma_unit(Frame& F, int unit) {
    const int j = unit & 15, hd = (unit >> 4) & 3, b = unit >> 6;
    const int tid = F.tid, dir = tid >> 8, ltid = tid & 255, c = ltid & 127, hf = ltid >> 7;
    const int lane = tid & 63, w = (tid >> 6) & 3, r32 = lane & 31, hh = lane >> 5;
    LAS unsigned char* L = F.lds + dir * HG_HALFB;
    const int udir = ((b * 4 + hd) * 2 + dir) * 16 + (dir ? 15 - j : j);
    const bf16_t* P = WSP(const bf16_t, WS_PROJ) + (size_t)(b * SEQ) * NIN;
    const int tbase = dir ? (j * SC + SC - 1) : (j * SC), tstep = dir ? -1 : 1;
    f32x16 S[4];
    if (PASS_C) { const f32x4* sin_ = (const f32x4*)(WSP(const float, WS_SLOC) + (size_t)udir * 16384) + (w * 16) * 64 + lane;
#pragma unroll
        for (int db = 0; db < 4; ++db)
#pragma unroll
            for (int g = 0; g < 4; ++g) { const f32x4 v4 = sin_[(db * 4 + g) * 64];
#pragma unroll
                for (int cc = 0; cc < 4; ++cc) S[db][4 * g + cc] = v4[cc]; }
    } else {
#pragma unroll
        for (int db = 0; db < 4; ++db)
#pragma unroll
            for (int i = 0; i < 16; ++i) S[db][i] = 0.f;
    }
    float lsum = 0.f;
    LAS unsigned char* RAW = F.lds + HG_RAW + dir * HG_RAWB;
    const char* Pb = (const char*)P;
    const unsigned cf0 = (unsigned)((dir ? C_FB : C_FF) + hd * 128) * 2u, cv0 = (unsigned)(C_V + hd * 128) * 2u, cq0 = (unsigned)(C_Q + hd * 128) * 2u;
#define HG_DMA(sc_) do { _Pragma("unroll") for (int k_ = 0; k_ < 2; ++k_) { const int i_ = 8 * w + 4 * k_ + (lane >> 4); \
        unsigned go_ = (unsigned)(tbase + tstep * (32 * (sc_) + i_)) * (unsigned)(NIN * 2) + (unsigned)(lane & 15) * 16u; asm volatile("" : "+v"(go_)); \
        __builtin_amdgcn_global_load_lds((const unsigned*)(Pb + cf0 + go_), (LAS unsigned*)(RAW + (8 * w + 4 * k_) * 256), 16, 0, 0); \
        __builtin_amdgcn_global_load_lds((const unsigned*)(Pb + cv0 + go_), (LAS unsigned*)(RAW + 8192 + (8 * w + 4 * k_) * 256), 16, 0, 0); \
        if (PASS_C) __builtin_amdgcn_global_load_lds((const unsigned*)(Pb + cq0 + go_), (LAS unsigned*)(RAW + 16384 + (8 * w + 4 * k_) * 256), 16, 0, 0); } } while (0)
    f32x4 cw[6];
    if (!PASS_C) {
#pragma unroll
        for (int q = 0; q < 3; ++q) { cw[2 * q] = *(const f32x4*)(F.conv_w + q * CD + lane * 8); cw[2 * q + 1] = *(const f32x4*)(F.conv_w + q * CD + lane * 8 + 4); } }
    if (PASS_C && ltid < 128) *(LAS float*)(L + HG_DS + ltid * 4) = F.norm_w[hd * 128 + ltid];
    HG_DMA(0);
    __builtin_amdgcn_s_waitcnt(0x0F70);
    HG_LDS_BARRIER();
    u32x4 fo0, fo1, fp0, fp1, fg0, fg1;
#define HG_FLUSH1(s_) do { const int rw_ = ltid >> 3, cq_ = ltid & 7, tok_ = tbase + tstep * (32 * (s_) + rw_); \
        const LAS unsigned char* op_ = F.lds + HG_OT_OFF + dir * 8192 + rw_ * 256 + cq_ * 32; fo0 = *(const LAS u32x4*)op_; fo1 = *(const LAS u32x4*)(op_ + 16); \
        bf16_t* od_ = WSP(bf16_t, WS_ODIR) + ((size_t)(b * SEQ) + (size_t)tok_) * 512 + hd * 128 + cq_ * 16; \
          \
        fp0 = *(const u32x4*)(od_ + (size_t)(1 - dir) * M * 512); fp1 = *(const u32x4*)(od_ + (size_t)(1 - dir) * M * 512 + 8); \
        { const bf16_t* gp_ = P + (size_t)tok_ * NIN + C_G + hd * 128 + cq_ * 16; fg0 = *(const u32x4*)gp_; fg1 = *(const u32x4*)(gp_ + 8); } \
        if ((s_) < 4) { *(u32x4*)(od_ + (size_t)dir * M * 512) = fo0; *(u32x4*)(od_ + (size_t)dir * M * 512 + 8) = fo1; } } while (0)
#define HG_FLUSH2(s_) do { const int rw_ = ltid >> 3, cq_ = ltid & 7, tok_ = tbase + tstep * (32 * (s_) + rw_); \
        float o_[16]; \
        _Pragma("unroll") for (int k_ = 0; k_ < 4; ++k_) { o_[2 * k_] = bflo(fo0[k_]) + bflo(fp0[k_]); o_[2 * k_ + 1] = bfhi(fo0[k_]) + bfhi(fp0[k_]); \
            o_[8 + 2 * k_] = bflo(fo1[k_]) + bflo(fp1[k_]); o_[9 + 2 * k_] = bfhi(fo1[k_]) + bfhi(fp1[k_]); } \
        float ss_ = 0.f; \
        _Pragma("unroll") for (int k_ = 0; k_ < 16; ++k_) ss_ += o_[k_] * o_[k_]; \
        ss_ += __shfl_xor(ss_, 1); ss_ += __shfl_xor(ss_, 2); ss_ += __shfl_xor(ss_, 4); \
        const float rs_ = 1.0f / sqrtf(ss_ * (1.0f / 128.0f) + RMS_EPS); \
        const LAS float* nwp_ = (const LAS float*)(L + HG_DS) + cq_ * 16;        \
        const f32x4 n0_ = *(const LAS f32x4*)nwp_, n1_ = *(const LAS f32x4*)(nwp_ + 4), n2_ = *(const LAS f32x4*)(nwp_ + 8), n3_ = *(const LAS f32x4*)(nwp_ + 12); \
        u32x4 w0_, w1_; \
        _Pragma("unroll") for (int k_ = 0; k_ < 4; ++k_) { \
            const float na_ = k_ < 2 ? n0_[2 * k_] : n1_[2 * k_ - 4], nb_ = k_ < 2 ? n0_[2 * k_ + 1] : n1_[2 * k_ - 3], nc_ = k_ < 2 ? n2_[2 * k_] : n3_[2 * k_ - 4], nd_ = k_ < 2 ? n2_[2 * k_ + 1] : n3_[2 * k_ - 3]; \
            w0_[k_] = pk2(o_[2 * k_] * rs_ * na_ * bflo(fg0[k_]), o_[2 * k_ + 1] * rs_ * nb_ * bfhi(fg0[k_])); \
            w1_[k_] = pk2(o_[8 + 2 * k_] * rs_ * nc_ * bflo(fg1[k_]), o_[9 + 2 * k_] * rs_ * nd_ * bfhi(fg1[k_])); } \
        bf16_t* yb_ = WSP(bf16_t, WS_YAB) + CD + ((size_t)(b * SEQ) + (size_t)tok_) * D + hd * 128 + cq_ * 16; \
        *(u32x4*)yb_ = w0_; *(u32x4*)(yb_ + 8) = w1_; } while (0)
    for (int sc = 0; sc < 8; ++sc) {
        if (PASS_C && sc >= 1) HG_FLUSH1(sc - 1);
        u32x4 cvb, cvc, cvh, cvcp, cvhp, cvcn, cvhn;
        if (!PASS_C) { const int t = unit * 64 + 8 * sc + (tid >> 6), l = t & (SEQ - 1); const bf16_t* pr = WSP(const bf16_t, WS_PROJ) + (size_t)t * NIN + lane * 8;
            const u32x4 zero4 = {0u, 0u, 0u, 0u};
            cvb = *(const u32x4*)(pr + C_CB); cvc = *(const u32x4*)(pr + C_CC); cvh = *(const u32x4*)(pr + C_CH);
            cvcp = zero4; cvhp = zero4; cvcn = zero4; cvhn = zero4;
            if (l > 0) { cvcp = *(const u32x4*)(pr - NIN + C_CC); cvhp = *(const u32x4*)(pr - NIN + C_CH); }
            if (l < SEQ - 1) { cvcn = *(const u32x4*)(pr + NIN + C_CC); cvhn = *(const u32x4*)(pr + NIN + C_CH); } }
        { unsigned short rl[16], rq[16], rv[16];
#pragma unroll
          for (int ii = 0; ii < 16; ++ii) { const LAS unsigned char* rp = RAW + (16 * hf + ii) * 256 + c * 2;
              rl[ii] = *(const LAS unsigned short*)(rp); rv[ii] = *(const LAS unsigned short*)(rp + 8192); rq[ii] = PASS_C ? *(const LAS unsigned short*)(rp + 16384) : (unsigned short)0; }
          float cs[16]; float run = 0.f;
#pragma unroll
          for (int ii = 0; ii < 16; ++ii) { run += bf2f(rl[ii]); cs[ii] = run; }
          const float tot = run; lsum += tot;
          unsigned ktp[8], vtp[8];
#pragma unroll
          for (int p = 0; p < 8; ++p) {
              float kt2[2], qt2[2];
#pragma unroll
              for (int q = 0; q < 2; ++q) { const int ii = 2 * p + q; const float x = hf ? cs[ii] : cs[ii] - tot;
                  const float kk = 1.0f - __expf(bf2f(rl[ii]));
                  kt2[q] = kk * __expf(-x); qt2[q] = PASS_C ? bf2f(rq[ii]) * __expf(x) : 0.f; }
              const unsigned kp = cvtpk_c(kt2[0], kt2[1]); ktp[p] = kp; vtp[p] = (unsigned)rv[2 * p] | ((unsigned)rv[2 * p + 1] << 16);
              if (PASS_C) { const unsigned qp = cvtpk_c(qt2[0], qt2[1]); const int i0 = 16 * hf + 2 * p;
                  *(LAS unsigned short*)(L + HG_KT + i0 * HG_RP + c * 2) = (unsigned short)(kp & 0xffffu); *(LAS unsigned short*)(L + HG_KT + (i0 + 1) * HG_RP + c * 2) = (unsigned short)(kp >> 16);
                  *(LAS unsigned short*)(L + HG_QT + i0 * HG_RP + c * 2) = (unsigned short)(qp & 0xffffu); *(LAS unsigned short*)(L + HG_QT + (i0 + 1) * HG_RP + c * 2) = (unsigned short)(qp >> 16); }
          }
          *(LAS u32x4*)(L + HG_KTT + c * HG_TP + hf * 32) = (u32x4){ktp[0], ktp[1], ktp[2], ktp[3]}; *(LAS u32x4*)(L + HG_KTT + c * HG_TP + hf * 32 + 16) = (u32x4){ktp[4], ktp[5], ktp[6], ktp[7]};
          *(LAS u32x4*)(L + HG_VT + c * HG_TP + hf * 32) = (u32x4){vtp[0], vtp[1], vtp[2], vtp[3]}; *(LAS u32x4*)(L + HG_VT + c * HG_TP + hf * 32 + 16) = (u32x4){vtp[4], vtp[5], vtp[6], vtp[7]};
          *(LAS float*)(L + (hf ? HG_SB : HG_SA) + c * 4) = __expf(tot);
        }
        if (PASS_C && sc >= 5) HG_FLUSH2(sc - 1);
        if (!PASS_C) __builtin_amdgcn_s_waitcnt(0x0F70);
        HG_LDS_BARRIER();
        if (sc + 1 < 8) HG_DMA(sc + 1);
        const LAS unsigned char* vrow = L + HG_VT + (32 * w + r32) * HG_TP;
        const LAS unsigned char* qrow = L + HG_QT + r32 * HG_RP;
        f32x16 O;
        if (PASS_C) {
            f32x16 X;
#pragma unroll
            for (int i = 0; i < 16; ++i) { X[i] = 0.f; O[i] = 0.f; }
            const LAS unsigned char* krow = L + HG_KT + r32 * HG_RP + hh * 16;
#pragma unroll
            for (int ks = 0; ks < 8; ++ks) { const bf16x8 a = *(const LAS bf16x8*)(krow + ks * 32), bq = *(const LAS bf16x8*)(qrow + hh * 16 + ks * 32); X = MFMA32(a, bq, X); }
#pragma unroll
            for (int i = 0; i < 16; ++i) X[i] = (crow(i, hh) <= r32) ? X[i] : 0.f;
            const bf16x8 pa0 = PACK8(X, 0), pa1 = PACK8(X, 1);
#pragma unroll
            for (int ks = 0; ks < 2; ++ks) { const u32x2 lo = *(const LAS u32x2*)(vrow + (16 * ks + 4 * hh) * 2), hi = *(const LAS u32x2*)(vrow + (16 * ks + 8 + 4 * hh) * 2);
                const bf16x8 vb = __builtin_bit_cast(bf16x8, (u32x4){lo.x, lo.y, hi.x, hi.y}); O = MFMA32(ks ? pa1 : pa0, vb, O); }
        }
#pragma unroll
        for (int db = 0; db < 4; ++db) { f32x4 f4[4];
#pragma unroll
            for (int g = 0; g < 4; ++g) f4[g] = *(const LAS f32x4*)(L + HG_SA + (32 * db + 8 * g + 4 * hh) * 4);
#pragma unroll
            for (int g = 0; g < 4; ++g)
#pragma unroll
                for (int cc = 0; cc < 4; ++cc) S[db][4 * g + cc] *= f4[g][cc]; }
        if (PASS_C) {
#pragma unroll
            for (int db = 0; db < 4; ++db)
#pragma unroll
                for (int ks = 0; ks < 2; ++ks) { const bf16x8 sb = PACK8(S[db], ks);
                    const u32x2 lo = *(const LAS u32x2*)(qrow + (32 * db + 16 * ks + 4 * hh) * 2), hi = *(const LAS u32x2*)(qrow + (32 * db + 16 * ks + 8 + 4 * hh) * 2);
                    const bf16x8 qa = __builtin_bit_cast(bf16x8, (u32x4){lo.x, lo.y, hi.x, hi.y}); O = MFMA32(qa, sb, O); }
        }
#pragma unroll
        for (int ks = 0; ks < 2; ++ks) { const bf16x8 vb2 = *(const LAS bf16x8*)(vrow + (16 * ks + 8 * hh) * 2);
#pragma unroll
            for (int db = 0; db < 4; ++db) { const bf16x8 ka = *(const LAS bf16x8*)(L + HG_KTT + (32 * db + r32) * HG_TP + (16 * ks + 8 * hh) * 2); S[db] = MFMA32(ka, vb2, S[db]); } }
#pragma unroll
        for (int db = 0; db < 4; ++db) { f32x4 f4[4];
#pragma unroll
            for (int g = 0; g < 4; ++g) f4[g] = *(const LAS f32x4*)(L + HG_SB + (32 * db + 8 * g + 4 * hh) * 4);
#pragma unroll
            for (int g = 0; g < 4; ++g)
#pragma unroll
                for (int cc = 0; cc < 4; ++cc) S[db][4 * g + cc] *= f4[g][cc]; }
        if (PASS_C) { LAS unsigned char* ot = F.lds + HG_OT_OFF + dir * 8192 + (32 * w + r32) * 2;
#pragma unroll
            for (int i = 0; i < 16; ++i) *(LAS unsigned short*)(ot + crow(i, hh) * 256) = (unsigned short)f2bf(O[i]); }
        if (!PASS_C) { const int t = unit * 64 + 8 * sc + (tid >> 6);
            float r[8];
#pragma unroll
            for (int p = 0; p < 4; ++p) {
                const float w0l = p < 2 ? cw[0][2 * p] : cw[1][2 * p - 4], w0h = p < 2 ? cw[0][2 * p + 1] : cw[1][2 * p - 3];
                const float w1l = p < 2 ? cw[2][2 * p] : cw[3][2 * p - 4], w1h = p < 2 ? cw[2][2 * p + 1] : cw[3][2 * p - 3];
                const float w2l = p < 2 ? cw[4][2 * p] : cw[5][2 * p - 4], w2h = p < 2 ? cw[4][2 * p + 1] : cw[5][2 * p - 3];
                r[2 * p]     = bflo(cvb[p]) * (w0l * (bflo(cvcp[p]) * bflo(cvhp[p])) + w1l * (bflo(cvc[p]) * bflo(cvh[p])) + w2l * (bflo(cvcn[p]) * bflo(cvhn[p])));
                r[2 * p + 1] = bfhi(cvb[p]) * (w0h * (bfhi(cvcp[p]) * bfhi(cvhp[p])) + w1h * (bfhi(cvc[p]) * bfhi(cvh[p])) + w2h * (bfhi(cvcn[p]) * bfhi(cvhn[p])));
            }
            u32x4 o; o.x = pk2(r[0], r[1]); o.y = pk2(r[2], r[3]); o.z = pk2(r[4], r[5]); o.w = pk2(r[6], r[7]);
            *(u32x4*)(WSP(bf16_t, WS_YAB) + (size_t)t * D + lane * 8) = o; }
        asm volatile("s_waitcnt vmcnt(0)" ::: "memory");
        HG_LDS_BARRIER();
    }
    if (PASS_C) { HG_FLUSH1(7); HG_FLUSH2(7); __syncthreads(); }
#undef HG_FLUSH1
#undef HG_FLUSH2
#undef HG_DMA
    if (!PASS_C) { f32x4* sl = (f32x4*)(WSP(float, WS_SLOC) + (size_t)udir * 16384) + (w * 16) * 64 + lane;
#pragma unroll
        for (int db = 0; db < 4; ++db)
#pragma unroll
            for (int g = 0; g < 4; ++g) sl[(db * 4 + g) * 64] = (f32x4){S[db][4 * g], S[db][4 * g + 1], S[db][4 * g + 2], S[db][4 * g + 3]};
        *(LAS float*)(L + HG_DS + (hf * 128 + c) * 4) = lsum;
        __syncthreads();
        if (hf == 0) WSP(float, WS_DEC)[udir * 128 + c] = __expf(*(const LAS float*)(L + HG_DS + c * 4) + *(const LAS float*)(L + HG_DS + (128 + c) * 4));
        __syncthreads();
    }
}
__device__ __forceinline__ void conv_phase(Frame& F) {
    const bf16_t* P = WSP(const bf16_t, WS_PROJ); bf16_t* YA = WSP(bf16_t, WS_YAB);
    const int nthr = F.G * NWAVES * 64;
    const u32x4 zero4 = {0u, 0u, 0u, 0u};
    for (int it0 = F.vcu * (NWAVES * 64) + F.tid; it0 < M * (CD / 8); it0 += 4 * nthr) {
        u32x4 cb[4], cc[4], ch[4], ccp[4], chp[4], ccn[4], chn[4];
#pragma unroll
        for (int q = 0; q < 4; ++q) { const int it = it0 + q * nthr; if (it < M * (CD / 8)) { const int t = it >> 6, c8 = (it & 63) * 8, l = t & (SEQ - 1); const size_t row = (size_t)t * NIN;
            cb[q] = *(const u32x4*)(P + row + C_CB + c8); cc[q] = *(const u32x4*)(P + row + C_CC + c8); ch[q] = *(const u32x4*)(P + row + C_CH + c8);
            ccp[q] = zero4; chp[q] = zero4; ccn[q] = zero4; chn[q] = zero4;
            if (l > 0) { ccp[q] = *(const u32x4*)(P + row - NIN + C_CC + c8); chp[q] = *(const u32x4*)(P + row - NIN + C_CH + c8); }
            if (l < SEQ - 1) { ccn[q] = *(const u32x4*)(P + row + NIN + C_CC + c8); chn[q] = *(const u32x4*)(P + row + NIN + C_CH + c8); } } }
#pragma unroll
        for (int q = 0; q < 4; ++q) { const int it = it0 + q * nthr; if (it < M * (CD / 8)) { const int t = it >> 6, c8 = (it & 63) * 8;
            const f32x4 w0a = *(const f32x4*)(F.conv_w + c8), w0b = *(const f32x4*)(F.conv_w + c8 + 4), w1a = *(const f32x4*)(F.conv_w + CD + c8), w1b = *(const f32x4*)(F.conv_w + CD + c8 + 4),
                        w2a = *(const f32x4*)(F.conv_w + 2 * CD + c8), w2b = *(const f32x4*)(F.conv_w + 2 * CD + c8 + 4);
            float r[8];
#pragma unroll
            for (int p = 0; p < 4; ++p) {
                const float w0l = p < 2 ? w0a[2 * p] : w0b[2 * p - 4], w0h = p < 2 ? w0a[2 * p + 1] : w0b[2 * p - 3];
                const float w1l = p < 2 ? w1a[2 * p] : w1b[2 * p - 4], w1h = p < 2 ? w1a[2 * p + 1] : w1b[2 * p - 3];
                const float w2l = p < 2 ? w2a[2 * p] : w2b[2 * p - 4], w2h = p < 2 ? w2a[2 * p + 1] : w2b[2 * p - 3];
                r[2 * p]     = bflo(cb[q][p]) * (w0l * (bflo(ccp[q][p]) * bflo(chp[q][p])) + w1l * (bflo(cc[q][p]) * bflo(ch[q][p])) + w2l * (bflo(ccn[q][p]) * bflo(chn[q][p])));
                r[2 * p + 1] = bfhi(cb[q][p]) * (w0h * (bfhi(ccp[q][p]) * bfhi(chp[q][p])) + w1h * (bfhi(cc[q][p]) * bfhi(ch[q][p])) + w2h * (bfhi(ccn[q][p]) * bfhi(chn[q][p])));
            }
            u32x4 o; o.x = pk2(r[0], r[1]); o.y = pk2(r[2], r[3]); o.z = pk2(r[4], r[5]); o.w = pk2(r[6], r[7]);
            *(u32x4*)(YA + (size_t)t * D + c8) = o; } }
    }
}
__device__ __forceinline__ void scan_phase(Frame& F) {
    const float* SL = WSP(const float, WS_SLOC); const float* DEC = WSP(const float, WS_DEC); float* SI = WSP(float, WS_SLOC);
    const int nthr = F.G * NWAVES * 64;
    for (int idx4 = F.vcu * (NWAVES * 64) + F.tid; idx4 < 32 * 4096; idx4 += nthr) {
        const int seq = idx4 >> 12, de = (idx4 & 4095) * 4, d0 = 32 * ((de >> 10) & 3) + 8 * ((de >> 8) & 3) + 4 * ((de >> 7) & 1);
        f32x4 sl[NSC], dc[NSC];
#pragma unroll
        for (int j = 0; j < NSC; ++j) { const int unit = seq * NSC + j; sl[j] = *(const f32x4*)(SL + (size_t)unit * 16384 + de); dc[j] = *(const f32x4*)(DEC + unit * 128 + d0); }
        asm volatile("s_waitcnt vmcnt(0)" ::: "memory");
        f32x4 Ecur = {0.f, 0.f, 0.f, 0.f};
#pragma unroll
        for (int j = 0; j < NSC; ++j) { const int unit = seq * NSC + j; *(f32x4*)(SI + (size_t)unit * 16384 + de) = Ecur; Ecur = dc[j] * Ecur + sl[j]; }
    }
}
__device__ __forceinline__ void rms_unit(Frame& F, int unit) {
    const int j = unit & 15, hd = (unit >> 4) & 3, b = unit >> 6;
    const bf16_t* O0 = WSP(const bf16_t, WS_ODIR); const bf16_t* O1 = O0 + (size_t)M * 512; const bf16_t* P = WSP(const bf16_t, WS_PROJ); bf16_t* YB = WSP(bf16_t, WS_YAB) + CD;
    asm volatile("s_waitcnt vmcnt(0)" ::: "memory");
    __syncthreads();
    const f32x4 nw = *(const f32x4*)(F.norm_w + hd * 128 + (F.tid & 31) * 4);
    for (int it0 = F.tid; it0 < SC * 32; it0 += 8 * NWAVES * 64) {
        u32x2 oa[8], ob[8]; u32x2 gg[8];
#pragma unroll
        for (int q = 0; q < 8; ++q) { const int it = it0 + q * (NWAVES * 64); const int t = b * SEQ + j * SC + (it >> 5), l4 = (it & 31) * 4; const size_t off = (size_t)t * 512 + hd * 128 + l4;
            oa[q] = *(const u32x2*)(O0 + off); ob[q] = *(const u32x2*)(O1 + off); gg[q] = *(const u32x2*)(P + (size_t)t * NIN + C_G + hd * 128 + l4); }
#pragma unroll
        for (int q = 0; q < 8; ++q) { const int it = it0 + q * (NWAVES * 64); const int t = b * SEQ + j * SC + (it >> 5), l4 = (it & 31) * 4;
            const f32x4 o = (f32x4){bflo(oa[q].x) + bflo(ob[q].x), bfhi(oa[q].x) + bfhi(ob[q].x), bflo(oa[q].y) + bflo(ob[q].y), bfhi(oa[q].y) + bfhi(ob[q].y)};
            float ss = (o[0] * o[0] + o[1] * o[1]) + (o[2] * o[2] + o[3] * o[3]);
#pragma unroll
            for (int s2 = 1; s2 < 32; s2 <<= 1) ss += __shfl_xor(ss, s2);
            const float rs = 1.0f / sqrtf(ss * (1.0f / 128.0f) + RMS_EPS);
            const u32x2 g = gg[q];
            u32x2 w; w.x = pk2(o[0] * rs * nw[0] * bflo(g.x), o[1] * rs * nw[1] * bfhi(g.x)); w.y = pk2(o[2] * rs * nw[2] * bflo(g.y), o[3] * rs * nw[3] * bfhi(g.y));
            *(u32x2*)(YB + (size_t)t * D + hd * 128 + l4) = w; }
    }
}

constexpr int WRT_STRIDE = 1028;
__device__ __forceinline__ void transpose_reduce32(float (&vals)[32], int lane) {
#pragma unroll
    for (int s = 0; s < 5; ++s) { const int half = 16 >> s; const bool up = (lane & half) != 0;
#pragma unroll
        for (int k = 0; k < half; ++k) { const float a = vals[k], b = vals[k + half]; const float keep = up ? b : a, send = up ? a : b; vals[k] = keep + __shfl_xor(send, half); } }
    vals[0] += __shfl_xor(vals[0], 32);
}
__device__ __forceinline__ void ln1_router_phase(Frame& F) {
    LAS float* wrT = (LAS float*)F.lds;
    LAS unsigned* cnt = (LAS unsigned*)(F.lds + 32 * WRT_STRIDE * 4);
    { f32x4 wv[16];
#pragma unroll
      for (int q = 0; q < 16; ++q) wv[q] = *(const f32x4*)(F.w_router + 4 * (F.tid + q * (NWAVES * 64)));
#pragma unroll
      for (int q = 0; q < 16; ++q) { const int i4 = F.tid + q * (NWAVES * 64), c = i4 >> 3, e0 = (i4 & 7) * 4;
#pragma unroll
          for (int i = 0; i < 4; ++i) wrT[(e0 + i) * WRT_STRIDE + c] = wv[q][i]; } }
    const bf16_t* OUTB = WSP(const bf16_t, WS_Z); bf16_t* HF = WSP(bf16_t, WS_HF); unsigned char* HQ = WSP(unsigned char, WS_HB);
    int* TOPI = WSP(int, WS_TOPI); float* TOPG = WSP(float, WS_TOPG); int* BLKCNT = WSP(int, WS_BLKCNT);
    const int lane = F.lane, e8 = lane & 7;
    float brv[4];
#pragma unroll
    for (int ch = 0; ch < 4; ++ch) brv[ch] = F.b_router[8 * ch + e8];
    for (int rb = F.rb0; rb < M / 64; rb += F.rbstep) {
        { const int l2 = fresh_lane(); if (F.wave == 0 && l2 < 32) cnt[l2] = 0u; }
        __syncthreads();
        for (int g = 0; g < 2; ++g) {
            const int row0 = rb * 64 + F.wave * 8 + 4 * g;
            f32x4 gv[4], bv[4];
            { unsigned go = (unsigned)lane * 16u; asm volatile("" : "+v"(go));
#pragma unroll
              for (int j = 0; j < 4; ++j) { gv[j] = *(const f32x4*)((const char*)F.ln1_g + go + 1024 * j); bv[j] = *(const f32x4*)((const char*)F.ln1_b + go + 1024 * j); } }
            f32x4 v[4][4];
            u32x2 ob[4][4], xb[4][4];
#pragma unroll
            for (int q = 0; q < 4; ++q) { const u32x2* xr = (const u32x2*)(WSP(const bf16_t, WS_XB) + (size_t)(row0 + q) * D) + lane; const u32x2* orow = (const u32x2*)(OUTB + (size_t)(row0 + q) * D) + lane;
#pragma unroll
                for (int j = 0; j < 4; ++j) { xb[q][j] = __builtin_nontemporal_load(xr + 64 * j); ob[q][j] = __builtin_nontemporal_load(orow + 64 * j); } }
#pragma unroll
            for (int q = 0; q < 4; ++q)
#pragma unroll
                for (int j = 0; j < 4; ++j) { v[q][j][0] = DN_ALPHA * bflo(xb[q][j].x) + bflo(ob[q][j].x); v[q][j][1] = DN_ALPHA * bfhi(xb[q][j].x) + bfhi(ob[q][j].x);
                    v[q][j][2] = DN_ALPHA * bflo(xb[q][j].y) + bflo(ob[q][j].y); v[q][j][3] = DN_ALPHA * bfhi(xb[q][j].y) + bfhi(ob[q][j].y); }
#pragma unroll
            for (int q = 0; q < 4; ++q) { float s = 0.f;
#pragma unroll
                for (int j = 0; j < 4; ++j) s += (v[q][j][0] + v[q][j][1]) + (v[q][j][2] + v[q][j][3]);
                const float mean = wave_sum(s) * (1.f / D); float s2 = 0.f;
#pragma unroll
                for (int j = 0; j < 4; ++j) { v[q][j] = v[q][j] - mean; s2 += (v[q][j][0] * v[q][j][0] + v[q][j][1] * v[q][j][1]) + (v[q][j][2] * v[q][j][2] + v[q][j][3] * v[q][j][3]); }
                const float rstd = 1.f / sqrtf(wave_sum(s2) * (1.f / D) + LN_EPS);
                u32x2* hr = (u32x2*)(HF + (size_t)(row0 + q) * D) + lane; unsigned* hq4 = (unsigned*)(HQ + (size_t)(row0 + q) * D) + lane;
#pragma unroll
                for (int j = 0; j < 4; ++j) { v[q][j] = v[q][j] * rstd * gv[j] + bv[j]; hr[64 * j] = (u32x2){pk2(v[q][j][0], v[q][j][1]), pk2(v[q][j][2], v[q][j][3])};
                    hq4[64 * j] = pk4_fp8(v[q][j][0] * Q_SH, v[q][j][1] * Q_SH, v[q][j][2] * Q_SH, v[q][j][3] * Q_SH); } }
            float lg[4];
#pragma unroll
            for (int ch = 0; ch < 4; ++ch) { float p[32];
#pragma unroll
                for (int e2 = 0; e2 < 8; ++e2) { f32x4 w[4];
#pragma unroll
                    for (int j = 0; j < 4; ++j) w[j] = *(const LAS f32x4*)(wrT + (8 * ch + e2) * WRT_STRIDE + 4 * lane + 256 * j);
#pragma unroll
                    for (int q = 0; q < 4; ++q) { f32x2 a2 = {0.f, 0.f};
#pragma unroll
                        for (int j = 0; j < 4; ++j) { a2 = __builtin_elementwise_fma((f32x2){v[q][j][0], v[q][j][1]}, (f32x2){w[j][0], w[j][1]}, a2); a2 = __builtin_elementwise_fma((f32x2){v[q][j][2], v[q][j][3]}, (f32x2){w[j][2], w[j][3]}, a2); }
                        p[q * 8 + e2] = a2.x + a2.y; } }
                transpose_reduce32(p, lane);
                lg[ch] = p[0] + brv[ch]; }
            float tv[TOPK]; int ti[TOPK];
#pragma unroll
            for (int k = 0; k < TOPK; ++k) { float bvv = lg[0]; int bi = e8;
#pragma unroll
                for (int ch = 1; ch < 4; ++ch) if (lg[ch] > bvv) { bvv = lg[ch]; bi = 8 * ch + e8; }
#pragma unroll
                for (int o = 1; o < 8; o <<= 1) { const float ov = __shfl_xor(bvv, o); const int oi = __shfl_xor(bi, o); const bool take = (ov > bvv) || (ov == bvv && oi < bi); bvv = take ? ov : bvv; bi = take ? oi : bi; }
                tv[k] = bvv; ti[k] = bi;
#pragma unroll
                for (int ch = 0; ch < 4; ++ch) if (bi == 8 * ch + e8) lg[ch] = -3.0e38f; }
            float ex[TOPK], se = 0.f;
#pragma unroll
            for (int k = 0; k < TOPK; ++k) { ex[k] = __expf(tv[k] - tv[0]); se += ex[k]; }
            const float inv = 1.0f / se;
            const int l3 = fresh_lane(), e8w = l3 & 7, rqw = (l3 & 31) >> 3;
            if (l3 < 32 && e8w < TOPK) { int myi = ti[0]; float myg = ex[0];
#pragma unroll
                for (int k = 1; k < TOPK; ++k) if (e8w == k) { myi = ti[k]; myg = ex[k]; }
                const int row = row0 + rqw;
                TOPI[row * TOPK + e8w] = myi; TOPG[row * TOPK + e8w] = myg * inv; __hip_atomic_fetch_add(&cnt[myi], 1u, __ATOMIC_RELAXED, __HIP_MEMORY_SCOPE_WORKGROUP); }
        }
        __syncthreads();
        { const int l2 = fresh_lane(); if (F.wave == 0 && l2 < 32) BLKCNT[rb * 32 + l2] = (int)cnt[l2]; }
        __syncthreads();
    }
}

__device__ __forceinline__ void routing_phase(Frame& F) {
    LAS int* ptot = (LAS int*)F.lds;
    LAS int* plo = ptot + 512;
    LAS int* tot = plo + 512;
    LAS int* lo = tot + 32;
    LAS int* startL = lo + 32;
    LAS int* baseL = startL + 64;
    LAS unsigned* cursor = (LAS unsigned*)(baseL + 32);
    const int* BLKCNT = WSP(const int, WS_BLKCNT); const int* TOPI = WSP(const int, WS_TOPI); const float* TOPG = WSP(const float, WS_TOPG);
    int* POSOF = WSP(int, WS_POSOF); int* SLOTTOK = WSP(int, WS_SLOTTOK); float* SLOTGATE = WSP(float, WS_SLOTGATE); int* META = WSP(int, WS_META);
    const int tid = F.tid;
    for (int rb = blockIdx.x; rb < M / 64; rb += F.G) {
        { const int part = tid >> 5, e = tid & 31; int st = 0, sl = 0;
            int cv[16];
#pragma unroll
            for (int i = 0; i < 16; ++i) cv[i] = BLKCNT[(part * 16 + i) * 32 + e];
#pragma unroll
            for (int i = 0; i < 16; ++i) { st += cv[i]; sl += (part * 16 + i < rb) ? cv[i] : 0; }
            ptot[part * 32 + e] = st; plo[part * 32 + e] = sl; }
        __syncthreads();
        if (tid < 32) { int st = 0, sl = 0;
            for (int p = 0; p < 16; ++p) { st += ptot[p * 32 + tid]; sl += plo[p * 32 + tid]; }
            tot[tid] = st; lo[tid] = sl; }
        __syncthreads();
        if (tid < 33) { int s = 0;
            for (int e2 = 0; e2 < tid; ++e2) s += (tot[e2] + 255) & ~255;
            startL[tid] = s; if (tid < 32) { baseL[tid] = s + lo[tid]; cursor[tid] = 0u; } }
        __syncthreads();
        if (tid < 256) { const int t = rb * 64 + (tid >> 2), k = tid & 3; const int e = TOPI[t * TOPK + k]; const float g = TOPG[t * TOPK + k];
            const unsigned r = __hip_atomic_fetch_add(&cursor[e], 1u, __ATOMIC_RELAXED, __HIP_MEMORY_SCOPE_WORKGROUP); const int pos = baseL[e] + (int)r;
            SLOTTOK[pos] = t; SLOTGATE[pos] = g; POSOF[t * TOPK + k] = pos; }
        if (rb < NE) { const int e = rb; const int p0 = startL[e] + tot[e], p1 = startL[e + 1];
            for (int p = p0 + tid; p < p1; p += NWAVES * 64) { SLOTTOK[p] = 0; SLOTGATE[p] = 0.f; } }
        if (rb == 0 && tid < 33) META[tid] = startL[tid] >> 8;
        __syncthreads();
    }
}

__device__ __forceinline__ void final_phase(Frame& F) {
    const bf16_t* HF = WSP(const bf16_t, WS_HF); const unsigned char* Y = WSP(const unsigned char, WS_Y); const int* POSOF = WSP(const int, WS_POSOF);
    const int gw = F.vcu * NWAVES + F.wave, NGW = F.G * NWAVES, lane = F.lane;
    f32x4 gv[4], bv[4];
#pragma unroll
    for (int j = 0; j < 4; ++j) { gv[j] = *(const f32x4*)(F.ln2_g + 4 * lane + 256 * j); bv[j] = *(const f32x4*)(F.ln2_b + 4 * lane + 256 * j); }
    const int nit = (M - gw + NGW - 1) / NGW;
    for (int base = 0; base < nit; base += 8) {
        int pv = 0; { const int it = base + (lane >> 2); if (lane < 32 && it < nit) pv = POSOF[(gw + it * NGW) * TOPK + (lane & 3)]; }
        for (int i2 = 0; i2 < 8 && base + i2 < nit; i2 += 2) {
            const bool two = (base + i2 + 1 < nit);
            const int rowA = gw + (base + i2) * NGW, rowB = two ? rowA + NGW : rowA;
            f32x4 va[4], vb[4]; unsigned ya[4][4], yb[4][4];
            { const u32x2* ha = (const u32x2*)(HF + (size_t)rowA * D) + lane; const u32x2* hb = (const u32x2*)(HF + (size_t)rowB * D) + lane;
#pragma unroll
              for (int j = 0; j < 4; ++j) { const u32x2 a = __builtin_nontemporal_load(ha + 64 * j), b2 = __builtin_nontemporal_load(hb + 64 * j); va[j] = (f32x4){bflo(a.x), bfhi(a.x), bflo(a.y), bfhi(a.y)}; vb[j] = (f32x4){bflo(b2.x), bfhi(b2.x), bflo(b2.y), bfhi(b2.y)}; } }
#pragma unroll
            for (int k = 0; k < TOPK; ++k) { const int pa = __builtin_amdgcn_readlane(pv, i2 * 4 + k), pb = __builtin_amdgcn_readlane(pv, (two ? i2 + 1 : i2) * 4 + k);
                const unsigned* ra = (const unsigned*)(Y + (size_t)pa * D) + lane; const unsigned* rb = (const unsigned*)(Y + (size_t)pb * D) + lane;
#pragma unroll
                for (int j = 0; j < 4; ++j) { ya[k][j] = __builtin_nontemporal_load(ra + 64 * j); yb[k][j] = __builtin_nontemporal_load(rb + 64 * j); } }
#pragma unroll
            for (int r = 0; r < 2; ++r) {
                f32x4 v[4];
#pragma unroll
                for (int j = 0; j < 4; ++j) { v[j] = (r ? vb[j] : va[j]) * DN_ALPHA;
#pragma unroll
                    for (int k = 0; k < TOPK; ++k) { const unsigned w = r ? yb[k][j] : ya[k][j]; const f32x2 lo = __builtin_amdgcn_cvt_pk_f32_fp8((int)w, false), hi = __builtin_amdgcn_cvt_pk_f32_fp8((int)w, true);
                        v[j][0] += lo.x * (1.0f / Q_SY); v[j][1] += lo.y * (1.0f / Q_SY); v[j][2] += hi.x * (1.0f / Q_SY); v[j][3] += hi.y * (1.0f / Q_SY); } }
                float s = 0.f;
#pragma unroll
                for (int j = 0; j < 4; ++j) s += (v[j][0] + v[j][1]) + (v[j][2] + v[j][3]);
                const float mean = wave_sum(s) * (1.f / D); float s2 = 0.f;
#pragma unroll
                for (int j = 0; j < 4; ++j) { v[j] = v[j] - mean; s2 += (v[j][0] * v[j][0] + v[j][1] * v[j][1]) + (v[j][2] * v[j][2] + v[j][3] * v[j][3]); }
                const float rstd = 1.f / sqrtf(wave_sum(s2) * (1.f / D) + LN_EPS);
                if (r == 0 || two) { f32x4* orow = (f32x4*)(F.out + (size_t)(r ? rowB : rowA) * D) + lane;
#pragma unroll
                    for (int j = 0; j < 4; ++j) __builtin_nontemporal_store(v[j] * rstd * gv[j] + bv[j], orow + 64 * j); }
            }
        }
    }
}

constexpr int NPH = 12;
constexpr int N_LAUNCHES = MK_N_LAUNCHES;
struct Args { const float* in[18]; float* out; unsigned char* ws; int ph_lo, ph_hi; };
__global__ void __launch_bounds__(NWAVES * 64, 2) skel_fwd(Args args) {
    extern __shared__ __attribute__((aligned(16))) unsigned char lds[];
    Frame F;
    F.lds = (LAS unsigned char*)lds;
    F.MISC = (volatile LAS unsigned*)(F.lds + MISC_OFF);
    F.tid = threadIdx.x; F.lane = F.tid & 63; F.wave = __builtin_amdgcn_readfirstlane(F.tid >> 6);
    F.G = gridDim.x; { const int bx = blockIdx.x; F.vcu = (F.G % 8 == 0) ? (bx % 8) * (F.G / 8) + bx / 8 : bx; }
    F.ws = args.ws; F.ctl = (gu32*)(args.ws + WS_CTL); F.out = args.out;
    F.x = args.in[0]; F.w_in = args.in[1]; F.conv_w = args.in[2]; F.p_a = args.in[3]; F.lb_logits = args.in[4]; F.norm_w = args.in[5]; F.p_b = args.in[6]; F.w_o = args.in[7];
    F.ln1_g = args.in[8]; F.ln1_b = args.in[9]; F.w_router = args.in[10]; F.b_router = args.in[11]; F.w1 = args.in[12]; F.b1 = args.in[13]; F.w2 = args.in[14]; F.b2 = args.in[15];
    F.ln2_g = args.in[16]; F.ln2_b = args.in[17];
    if (F.tid < 32) F.MISC[F.tid] = 0u;
    __syncthreads();
    XcdBarrier bar; bar.bar = (unsigned*)(F.ctl + CW_BAR); bar.x = 0; bar.st = nullptr;
    if (N_LAUNCHES != NPH) bar = xcd_barrier_post((unsigned*)(F.ctl + CW_BAR), F.MISC + 8, F.tid == 0);
#define GRID_BAR() do { if (N_LAUNCHES != NPH) xcd_barrier(bar, F.wave == 0 && fresh_lane() == 0); } while (0)
    const bool chain = (N_LAUNCHES == 1) && (F.G == NB * NH * NSC) && (F.G % 8 == 0);
    const int g_pm = __builtin_amdgcn_readfirstlane((F.vcu >> 5) * 8 + ((F.vcu & 31) >> 2)), g_m = __builtin_amdgcn_readfirstlane(F.vcu & 3);
    if (chain && F.tid == 0) __hip_atomic_store((unsigned*)F.ctl + CW_GX + g_pm * 32 + g_m, xb_xcc_id() + 1u, __ATOMIC_RELAXED, __HIP_MEMORY_SCOPE_AGENT);
    F.rb0 = chain ? g_pm * 4 + g_m : (int)blockIdx.x; F.rbstep = chain ? M / 64 : F.G;
#define SEAM(k, s_) do { if (BOTH(k)) { if (chain) grp_barrier((unsigned*)F.ctl, (s_), g_pm, F.wave == 0 && fresh_lane() == 0, bar.bar, F.MISC + 17); else GRID_BAR(); } } while (0)
    const int lo = args.ph_lo, hi = args.ph_hi;
#define IN(k) (lo <= (k) && (k) < hi && (F.lane = fresh_lane(), F.tid = F.wave * 64 + F.lane, true))
#define BOTH(k) (IN(k) && IN((k) + 1))
#define REP(k) for (int rep_ = 0; rep_ < 1 + ((PROBE_DUP_MASK >> (k)) & 1); ++rep_)
    LAS unsigned* tokbuf = (LAS unsigned*)(F.lds + TOKBUF_OFF);
    LAS int* moets = (LAS int*)(F.lds + MOETS_OFF);

    if (IN(0)) { REP(0) p0_prologue<0>(F); if (BOTH(0)) GRID_BAR(); }
    if (IN(1)) {
        REP(1) {
        pg8::StaticOrder SQ; SQ.init(WSP(char, WS_XQ), WSP(char, WS_WINQ), M, NIN - C_GA, D / 2, F.G, (int)blockIdx.x);
        pg8::EpiProj EQ{WSP(bf16_t, WS_PROJ), WSP(const float, WS_LB), C_GA / 256, 1.0f / (Q_SX * Q_SWI)};
        pg8::gemm_phase<false, true, true>(F.lds, tokbuf, nullptr, D / 2, SQ, EQ, F.wave);
        pg8::StaticOrder S; S.init(WSP(char, WS_XB), WSP(char, WS_WIN), M, C_GA, D, F.G, (int)blockIdx.x);
        pg8::EpiProj E{WSP(bf16_t, WS_PROJ), WSP(const float, WS_LB), 0, 1.0f};
        pg8::gemm_phase<false, true, false>(F.lds, tokbuf, nullptr, D, S, E, F.wave);
        }
        if (BOTH(1)) GRID_BAR();
    }
    if (IN(2)) {
        REP(2) { for (int u = F.vcu; u < NB * NH * NSC; u += F.G) hgrn_mfma_unit<false>(F, u); }
        if (BOTH(2)) GRID_BAR();
    }
    if (IN(3)) { REP(3) scan_phase(F); if (BOTH(3)) GRID_BAR(); }
    if (IN(4)) {
        REP(4) { if (chain) hgrn_mfma_unit<true>(F, ((g_pm >> 4) << 6) | (g_m << 4) | (g_pm & 15)); else for (int u = F.vcu; u < NB * NH * NSC; u += F.G) { hgrn_mfma_unit<true>(F, u); } }
        SEAM(4, 0);
    }
    if (IN(5)) {
        REP(5) {
        pg8::StaticOrder S; S.init(WSP(char, WS_YAB), WSP(char, WS_PAB), M, D, D, F.G, (int)blockIdx.x); if (chain) { S.fix_pm = g_pm; S.fix_pn = g_m; }
        pg8::EpiMix E{WSP(const bf16_t, WS_PROJ), WSP(bf16_t, WS_MIX)};
        pg8::gemm_phase<false, false, false>(F.lds, tokbuf, nullptr, D, S, E, F.wave);
        }
        SEAM(5, 1);
    }
    if (IN(6)) {
        REP(6) {
        pg8::StaticOrder S; S.init(WSP(char, WS_MIX), WSP(char, WS_WO), M, D, D, F.G, (int)blockIdx.x); if (chain) { S.fix_pm = g_pm; S.fix_pn = g_m; }
        pg8::EpiResid E{WSP(bf16_t, WS_Z)};
        pg8::gemm_phase<false, false, false>(F.lds, tokbuf, nullptr, D, S, E, F.wave);
        }
        SEAM(6, 2);
    }
    if (IN(7)) { REP(7) ln1_router_phase(F); if (BOTH(7)) GRID_BAR(); }
    if (IN(8)) { REP(8) { routing_phase(F); __syncthreads(); p0_prologue<1>(F); } if (BOTH(8)) GRID_BAR(); }
    if (IN(9)) {
        if (F.tid < 33) moets[F.tid] = WSP(const int, WS_META)[F.tid];
        __syncthreads();
        REP(9) {
        pg8::MoeOrder S{WSP(const char, WS_HB), WSP(const char, WS_W1), D / 2, 8, F.G, (int)blockIdx.x, moets, true, 2};
        pg8::EpiSwiglu E{WSP(unsigned char, WS_ACT), F.b1};
        pg8::gemm_phase<true, true, true>(F.lds, tokbuf, WSP(const int, WS_SLOTTOK), D / 2, S, E, F.wave);
        }
        if (BOTH(9)) GRID_BAR();
    }
    if (IN(10)) {
        if (F.tid < 33) moets[F.tid] = WSP(const int, WS_META)[F.tid];
        __syncthreads();
        REP(10) {
        pg8::MoeOrder S{WSP(const char, WS_ACT), WSP(const char, WS_W2), DFF / 2, 4, F.G, (int)blockIdx.x, moets, false, 4};
        pg8::EpiMoeOut E{WSP(unsigned char, WS_Y), F.b2, WSP(const float, WS_SLOTGATE)};
        pg8::gemm_phase<false, true, true>(F.lds, tokbuf, nullptr, DFF / 2, S, E, F.wave);
        }
        if (BOTH(10)) GRID_BAR();
    }
    if (IN(11)) { REP(11) final_phase(F); }
#undef IN
#undef BOTH
}

extern "C" void kernel_launch(void* const* d_in, const int* in_sizes, int n_in, void* d_out, int out_size, void* d_ws, size_t ws_size, hipStream_t stream) {
    static int grid = 0;
    if (grid == 0) {
        if (n_in != 18 || in_sizes[0] != M * D || out_size != M * D || ws_size < WS_END) { fprintf(stderr, "kernel_launch: unexpected shapes / workspace (n_in %d, ws %zu)\n", n_in, ws_size); grid = -1; return; }
        int dev = 0, cus = 0, per_cu = 0;
        if (hipGetDevice(&dev) != hipSuccess || hipDeviceGetAttribute(&cus, hipDeviceAttributeMultiprocessorCount, dev) != hipSuccess) { grid = -1; return; }
        if (hipFuncSetAttribute((const void*)skel_fwd, hipFuncAttributeMaxDynamicSharedMemorySize, LDS_BYTES) != hipSuccess) { fprintf(stderr, "kernel_launch: hipFuncSetAttribute failed\n"); grid = -1; return; }
        if (hipOccupancyMaxActiveBlocksPerMultiprocessor(&per_cu, (const void*)skel_fwd, NWAVES * 64, LDS_BYTES) != hipSuccess || per_cu < 1)
            fprintf(stderr, "kernel_launch: note: occupancy query reports %d workgroups per CU\n", per_cu);
        (void)hipGetLastError();
        grid = cus;
    }
    if (grid < 0) return;
    if (hipMemsetAsync((char*)d_ws + WS_CTL, 0, CTL_ZERO_BYTES, stream) != hipSuccess) return;
    Args a{};
    for (int i = 0; i < 18; ++i) a.in[i] = (const float*)d_in[i];
    a.out = (float*)d_out; a.ws = (unsigned char*)d_ws;
    if (N_LAUNCHES == 1) { a.ph_lo = 0; a.ph_hi = NPH; hipLaunchKernelGGL(skel_fwd, dim3(grid), dim3(NWAVES * 64), LDS_BYTES, stream, a); }
    else { for (int p = 0; p < NPH; ++p) { a.ph_lo = p; a.ph_hi = p + 1; hipLaunchKernelGGL(skel_fwd, dim3(grid), dim3(NWAVES * 64), LDS_BYTES, stream, a); } }
}
```
